# Optimizing an MI355X kernel written in HIP

```python
import jax, jax.numpy as jnp
from jax import lax
import numpy as np

D_MODEL = 1024
BATCH = 1
SEQ = 16384
DEPTH = 1

HEAD_DIM = 64
ATTN_GROUPS = ((128, 1), (512, 4), (2048, 16))
HEADS_PER_GROUP = 4
N_ATTN_HEADS = HEADS_PER_GROUP * len(ATTN_GROUPS)
ATTN_WIDTH = N_ATTN_HEADS * HEAD_DIM
ATTN_OUT_WIDTH = HEADS_PER_GROUP * HEAD_DIM
POOL_WINDOWS = (2, 4, 8, 16)
POOL_GROUP_WIDTH = D_MODEL // 16
POOL_WIDTH = POOL_GROUP_WIDTH * len(POOL_WINDOWS)
N_BRANCHES = 2
IN_WIDTH = 3 * ATTN_WIDTH + POOL_WIDTH + N_BRANCHES * D_MODEL
FFN_HIDDEN = -(-8 * D_MODEL // (3 * 256)) * 256
ROPE_THETA = 10000.0
EPS = 1e-6
NEG_INF = -1e30

kernel_name = "hybrid_dilated_attn_pool_gated_swiglu"


def rms_norm(x, g):
    xf = x.astype(jnp.float32)
    y = xf * lax.rsqrt(jnp.mean(xf * xf, axis=-1, keepdims=True) + EPS) * g.astype(jnp.float32)
    return y.astype(x.dtype)


def apply_rope(t):
    S, Dh = t.shape[1], t.shape[3]
    half = Dh // 2
    inv_freq = ROPE_THETA ** (-(jnp.arange(half, dtype=jnp.float32) * 2.0 / Dh))
    ang = jnp.arange(S, dtype=jnp.float32)[:, None] * inv_freq[None, :]
    cos = jnp.cos(ang)[None, :, None, :]
    sin = jnp.sin(ang)[None, :, None, :]
    tf = t.astype(jnp.float32)
    t1, t2 = tf[..., :half], tf[..., half:]
    out = jnp.concatenate([t1 * cos - t2 * sin, t2 * cos + t1 * sin], axis=-1)
    return out.astype(t.dtype)


def dilated_window_attention(q, k, v, window, dilation):
    B, S, H, Dh = q.shape
    steps = window // dilation
    span = steps * dilation
    S_pad = -(-S // span) * span
    pad = ((0, 0), (0, S_pad - S), (0, 0), (0, 0))
    q, k, v = jnp.pad(q, pad), jnp.pad(k, pad), jnp.pad(v, pad)
    nb = S_pad // span
    qs = q.reshape(B, nb, steps, dilation, H, Dh)
    ks = k.reshape(B, nb, steps, dilation, H, Dh)
    vs = v.reshape(B, nb, steps, dilation, H, Dh)

    def with_prev(t):
        prev = jnp.concatenate([jnp.zeros_like(t[:, :1]), t[:, :-1]], axis=1)
        return jnp.concatenate([prev, t], axis=2)

    kk, vv = with_prev(ks), with_prev(vs)
    scale = HEAD_DIM ** -0.5
    s = jnp.einsum('bnqrhd,bnkrhd->bnrhqk', qs, kk, preferred_element_type=jnp.float32) * scale
    qi = jnp.arange(steps)[:, None]
    kj = jnp.arange(2 * steps)[None, :]
    band = (kj >= qi) & (kj <= qi + steps)
    has_prev = (jnp.arange(nb) > 0)[:, None, None]
    valid = band[None] & (has_prev | (kj >= steps)[None])
    s = jnp.where(valid[None, :, None, None], s, NEG_INF)
    m = jnp.max(s, axis=-1, keepdims=True)
    p = jnp.exp(s - m)
    den = jnp.sum(p, axis=-1)
    lse = m[..., 0] + jnp.log(den)
    out = jnp.einsum('bnrhqk,bnkrhd->bnqrhd', p.astype(v.dtype), vv, preferred_element_type=jnp.float32)
    out = out / jnp.transpose(den, (0, 1, 4, 2, 3))[..., None]
    out = out.reshape(B, S_pad, H, Dh)[:, :S]
    lse = jnp.transpose(lse, (0, 1, 4, 2, 3)).reshape(B, S_pad, H)[:, :S]
    return out, lse


def multiscale_pool(u, w_mix, scale):
    B, S, _ = u.shape
    G, Cg = len(POOL_WINDOWS), POOL_GROUP_WIDTH
    ug = u.astype(jnp.float32).reshape(B, S, G, Cg)
    c0 = jnp.concatenate([jnp.zeros((B, 1, G, Cg), jnp.float32), jnp.cumsum(ug, axis=1)], axis=1)
    outs = []
    for g, w in enumerate(POOL_WINDOWS):
        c = c0[:, :, g]
        lag = jnp.concatenate([jnp.zeros((B, w - 1, Cg), jnp.float32), c[:, :S - w + 1]], axis=1)
        cnt = jnp.minimum(jnp.arange(S) + 1, w).astype(jnp.float32)[None, :, None]
        z = (c[:, 1:] - lag) / cnt - ug[:, :, g]
        outs.append(jnp.einsum('bsc,cd->bsd', z, w_mix[g].astype(jnp.float32)))
    y = jnp.concatenate(outs, axis=-1) * scale.astype(jnp.float32)
    return y.astype(u.dtype)


def setup_inputs(seed: int = 0) -> dict:
    key = jax.random.key(seed)
    ks = jax.random.split(key, 13)
    f32 = jnp.float32

    def w(k, shape, fan_in):
        return jax.random.normal(k, shape, f32) * (fan_in ** -0.5)

    def gain(k, n):
        return 1.0 + 0.1 * jax.random.normal(k, (DEPTH, n), f32)

    return {
        "x": jax.random.normal(ks[0], (BATCH, SEQ, D_MODEL), f32),
        "g_pre_mix": gain(ks[1], D_MODEL),
        "w_in": w(ks[2], (DEPTH, D_MODEL, IN_WIDTH), D_MODEL),
        "w_pool_mix": w(ks[3], (DEPTH, len(POOL_WINDOWS), POOL_GROUP_WIDTH, POOL_GROUP_WIDTH), POOL_GROUP_WIDTH),
        "pool_scale": gain(ks[4], POOL_WIDTH),
        "w_proj_attn": w(ks[5], (DEPTH, ATTN_OUT_WIDTH, D_MODEL), ATTN_OUT_WIDTH),
        "w_proj_pool": w(ks[6], (DEPTH, POOL_WIDTH, D_MODEL), POOL_WIDTH),
        "w_out": w(ks[7], (DEPTH, D_MODEL, D_MODEL), D_MODEL),
        "g_post_mix": gain(ks[8], D_MODEL),
        "g_pre_ffn": gain(ks[9], D_MODEL),
        "w_gate_up": w(ks[10], (DEPTH, D_MODEL, 2 * FFN_HIDDEN), D_MODEL),
        "w_down": w(ks[11], (DEPTH, FFN_HIDDEN, D_MODEL), FFN_HIDDEN),
        "g_post_ffn": gain(ks[12], D_MODEL),
    }


def reference(x, g_pre_mix, w_in, w_pool_mix, pool_scale, w_proj_attn, w_proj_pool, w_out,
              g_post_mix, g_pre_ffn, w_gate_up, w_down, g_post_ffn):
    B, S, _ = x.shape
    for l in range(DEPTH):
        h = rms_norm(x, g_pre_mix[l])
        proj = h @ w_in[l]
        o0 = 0
        q = proj[..., o0:o0 + ATTN_WIDTH].reshape(B, S, N_ATTN_HEADS, HEAD_DIM); o0 += ATTN_WIDTH
        k = proj[..., o0:o0 + ATTN_WIDTH].reshape(B, S, N_ATTN_HEADS, HEAD_DIM); o0 += ATTN_WIDTH
        v = proj[..., o0:o0 + ATTN_WIDTH].reshape(B, S, N_ATTN_HEADS, HEAD_DIM); o0 += ATTN_WIDTH
        u = proj[..., o0:o0 + POOL_WIDTH]; o0 += POOL_WIDTH
        gates = proj[..., o0:o0 + N_BRANCHES * D_MODEL]

        q = apply_rope(q)
        k = apply_rope(k)
        outs, lses = [], []
        for gi, (window, dilation) in enumerate(ATTN_GROUPS):
            hs = slice(gi * HEADS_PER_GROUP, (gi + 1) * HEADS_PER_GROUP)
            o_g, lse_g = dilated_window_attention(q[:, :, hs], k[:, :, hs], v[:, :, hs], window, dilation)
            outs.append(o_g)
            lses.append(lse_g)
        wts = jax.nn.softmax(jnp.stack(lses, axis=0), axis=0)
        o_attn = jnp.sum(wts[..., None] * jnp.stack(outs, axis=0), axis=0)
        o_attn = o_attn.reshape(B, S, ATTN_OUT_WIDTH).astype(x.dtype)

        y_pool = multiscale_pool(u, w_pool_mix[l], pool_scale[l])

        gate_a = jax.nn.sigmoid(gates[..., :D_MODEL])
        gate_p = jax.nn.sigmoid(gates[..., D_MODEL:])
        merged = gate_a * (o_attn @ w_proj_attn[l]) + gate_p * (y_pool @ w_proj_pool[l])
        x = x + rms_norm(merged @ w_out[l], g_post_mix[l])

        h2 = rms_norm(x, g_pre_ffn[l])
        gu = h2 @ w_gate_up[l]
        a, b = gu[..., :FFN_HIDDEN], gu[..., FFN_HIDDEN:]
        x = x + rms_norm((jax.nn.silu(a) * b) @ w_down[l], g_post_ffn[l])
    return x
```

```cpp
#include <hip/hip_runtime.h>
#include <hip/hip_cooperative_groups.h>
#include <cstdio>
#include <cstdint>
#include <cmath>
namespace cg = cooperative_groups;
namespace pg8 {
#define PG8_LAS __attribute__((address_space(3)))
typedef unsigned short bf16_t;
typedef short bf16x8 __attribute__((ext_vector_type(8)));
typedef float f32x4 __attribute__((ext_vector_type(4)));
typedef unsigned u32x4 __attribute__((ext_vector_type(4)));
constexpr int BM = 256, BK = 64, HALF = 128, HTB = HALF * BK * 2  , STAGE_BYTES = 8 * HTB, NXCD = 8, WGM = 8;

__host__ __device__ __forceinline__ int lds_byte(int r, int c) { const int st = (r >> 4) * 2 + (c >> 5), rr = r & 15, cc = c & 31, ob = rr * 64 + cc * 2; return st * 1024 + (ob ^ (((ob >> 9) & 1) << 5)); }
__host__ __device__ __forceinline__ void stage_rc(int b, int& R, int& C) { const int st = b / 1024, sb = b % 1024, swz = sb ^ (((sb >> 9) & 1) << 5); R = (st >> 1) * 16 + swz / 64; C = (st & 1) * 32 + (swz % 64) / 2; }
__host__ __device__ __forceinline__ int perm32(int rho) { const int n = rho >> 4, i = rho & 15; return 8 * (i >> 2) + 4 * n + (i & 3); }

struct Unit { int pm, pn; };
struct Gemm { const bf16_t* A; const bf16_t* Bt; int M, N, K; };

struct StaticOrder {
    int nM, nN, nwg, G, c;
    __host__ __device__ void init(int M, int N, int G_, int c_) { nM = M / BM; nN = N / BM; nwg = nM * nN; G = G_; c = c_; }
    __host__ __device__ bool next(int i, Unit& u) const {
        const long L = (long)i * G + c; if (L >= nwg) return false;
        int wgid = (int)L; { const int q = nwg / NXCD, r = nwg % NXCD, xcd = wgid % NXCD, off = wgid / NXCD; wgid = (xcd < r ? xcd * (q + 1) : r * (q + 1) + (xcd - r) * q) + off; }
        const int nig = WGM * nN, gid = wgid / nig, fm = gid * WGM, gsz = (nM - fm) < WGM ? (nM - fm) : WGM;
        u.pm = fm + ((wgid % nig) % gsz); u.pn = (wgid % nig) / gsz; return true;
    }
    __device__ __forceinline__ void a_ready(const Unit&) const {}
    __device__ __forceinline__ void done(const Unit&) const {}
};
__device__ __forceinline__ unsigned cvt_pk_bf16(float lo, float hi) { unsigned r; asm volatile("v_cvt_pk_bf16_f32 %0, %1, %2" : "=v"(r) : "v"(lo), "v"(hi)); return r; }
typedef float f32x2 __attribute__((ext_vector_type(2)));
template <class Epi, class Sched, bool ALIGN_EPI = false, bool SP2 = false>
__device__ __forceinline__ void gemm_phase(PG8_LAS unsigned char* lds, const Gemm g, const Sched& S, const Epi& E, const int wid, const int lane) {
    const int tid = wid * 64 + lane, wr = wid >> 2, wc = wid & 3, fr = lane & 15, fq = lane >> 4;
    const int K = g.K, nt = K / BK;
    unsigned voffA[2], voffB[2];
#pragma unroll
    for (int i = 0; i < 2; ++i) { int R, C; stage_rc(tid * 16 + i * 8192, R, C); const int Rb = Epi::PERM ? ((R & ~31) + perm32(R & 31)) : R;
        voffA[i] = (unsigned)(R * K + C) * 2u; voffB[i] = (unsigned)(Rb * K + C) * 2u; }
    const size_t kstep = (size_t)(BK * 2);
    const size_t hstep = (size_t)HALF * K * 2;
    const size_t tstep = 2 * hstep;
    const unsigned ldsw = (unsigned)wid * 1024u;
    const int aoff = lds_byte(wr * 64 + fr, fq * 8), boff = lds_byte(wc * 32 + fr, fq * 8);
#define PG8_SA(b, h) (((b) * 2 + (h)) * HTB)
#define PG8_SB(b, h) ((4 + (b) * 2 + (h)) * HTB)
#define PG8_STAGE(bufoff, gbase, voff) do { _Pragma("unroll") for (int _i = 0; _i < 2; ++_i) \
        __builtin_amdgcn_global_load_lds((const unsigned*)((const char*)(gbase) + (voff)[_i]), (PG8_LAS unsigned*)(lds + (bufoff) + ldsw + _i * 8192), 16, 0, 0); } while (0)
#define PG8_LDA(dst, b, h) do { _Pragma("unroll") for (int m = 0; m < 4; ++m) _Pragma("unroll") for (int k = 0; k < 2; ++k) dst[m][k] = *(const PG8_LAS bf16x8*)(lds + PG8_SA(b, h) + aoff + m * 2048 + k * 1024); } while (0)
#define PG8_LDB(dst, b, h) do { _Pragma("unroll") for (int n = 0; n < 2; ++n) _Pragma("unroll") for (int k = 0; k < 2; ++k) dst[n][k] = *(const PG8_LAS bf16x8*)(lds + PG8_SB(b, h) + boff + n * 2048 + k * 1024); } while (0)
#define PG8_MMA(ai, bj, At, Bt) do { __builtin_amdgcn_s_setprio(1); _Pragma("unroll") for (int m = 0; m < 4; ++m) _Pragma("unroll") for (int n = 0; n < 2; ++n) _Pragma("unroll") for (int k = 0; k < 2; ++k) \
        acc[ai][bj][m][n] = __builtin_amdgcn_mfma_f32_16x16x32_bf16(Bt[n][k], At[m][k], acc[ai][bj][m][n], 0, 0, 0); __builtin_amdgcn_s_setprio(0); } while (0)
#define PG8_WAIT_V(n) asm volatile("s_waitcnt vmcnt(" #n ")" ::: "memory")
#define PG8_WAIT_L(n) asm volatile("s_waitcnt lgkmcnt(" #n ")" ::: "memory")
#define PG8_BAR __builtin_amdgcn_s_barrier()
#define PG8_SCHED __builtin_amdgcn_sched_barrier(0)
    Unit cur, nxt; int ui = 0;
    if (!S.next(0, cur)) return;
    f32x4 acc[2][2][4][2];
#pragma unroll
    for (int a = 0; a < 2; ++a)
#pragma unroll
        for (int b = 0; b < 2; ++b)
#pragma unroll
            for (int m = 0; m < 4; ++m)
#pragma unroll
                for (int n = 0; n < 2; ++n) acc[a][b][m][n] = (f32x4){0.f, 0.f, 0.f, 0.f};
    bf16x8 At[4][2], B0[2][2], B1[2][2];
    const char* cA = (const char*)g.A + (size_t)cur.pm * tstep; const char* cB = (const char*)g.Bt + (size_t)cur.pn * tstep;
    S.a_ready(cur);
    if constexpr (SP2) {
        PG8_STAGE(PG8_SB(0, 0), cB, voffB); PG8_STAGE(PG8_SB(0, 1), cB + hstep, voffB); PG8_STAGE(PG8_SA(0, 0), cA, voffA); PG8_STAGE(PG8_SA(0, 1), cA + hstep, voffA);
        if (wr == 1) PG8_BAR;
        PG8_WAIT_V(2); PG8_BAR;
        PG8_STAGE(PG8_SB(1, 0), cB + kstep, voffB); PG8_STAGE(PG8_SA(1, 0), cA + kstep, voffA); PG8_STAGE(PG8_SB(1, 1), cB + hstep + kstep, voffB);
        PG8_WAIT_V(6); PG8_BAR;
    } else {
        PG8_STAGE(PG8_SB(0, 0), cB, voffB); PG8_STAGE(PG8_SA(0, 0), cA, voffA); PG8_STAGE(PG8_SB(0, 1), cB + hstep, voffB); PG8_STAGE(PG8_SA(0, 1), cA + hstep, voffA);
        if (wr == 1) PG8_BAR;
        PG8_WAIT_V(4); PG8_BAR;
        PG8_STAGE(PG8_SB(1, 0), cB + kstep, voffB); PG8_STAGE(PG8_SA(1, 0), cA + kstep, voffA); PG8_STAGE(PG8_SB(1, 1), cB + hstep + kstep, voffB);
        PG8_WAIT_V(6); PG8_BAR;
    }
    for (;;) {
        const bool has_next = S.next(ui + 1, nxt);
        const char* nA = has_next ? (const char*)g.A + (size_t)nxt.pm * tstep : cA; const char* nB = has_next ? (const char*)g.Bt + (size_t)nxt.pn * tstep : cB;
        for (int t = 0; t < nt; t += 2) {
            if constexpr (Epi::HAS_MID) { if (t == (nt >> 1)) E.mid(acc, cur, wr, wc, fr, fq); }
            const bool last = (t == nt - 2);
            const char* a1 = cA + (size_t)(t + 1) * kstep;
            const char* a2 = last ? nA : cA + (size_t)(t + 2) * kstep; const char* b2 = last ? nB : cB + (size_t)(t + 2) * kstep;
            const char* a3 = a2 + kstep; const char* b3 = b2 + kstep;
            if (last && has_next) S.a_ready(nxt);
            if constexpr (SP2) {
            PG8_LDB(B0, 0, 0); PG8_LDB(B1, 0, 1); PG8_SCHED; PG8_LDA(At, 0, 0); PG8_STAGE(PG8_SA(1, 1), a1 + hstep, voffA);
            PG8_WAIT_V(8); PG8_WAIT_L(0); PG8_BAR; PG8_MMA(0, 0, At, B0); PG8_MMA(0, 1, At, B1); PG8_BAR; PG8_SCHED;
            PG8_LDA(At, 0, 1); PG8_STAGE(PG8_SB(0, 0), b2, voffB); PG8_STAGE(PG8_SB(0, 1), b2 + hstep, voffB); PG8_STAGE(PG8_SA(0, 0), a2, voffA);
            PG8_WAIT_V(8); PG8_WAIT_L(0); PG8_BAR; PG8_MMA(1, 0, At, B0); PG8_MMA(1, 1, At, B1); PG8_BAR; PG8_SCHED;
            PG8_LDB(B0, 1, 0); PG8_LDB(B1, 1, 1); PG8_SCHED; PG8_LDA(At, 1, 0); PG8_STAGE(PG8_SA(0, 1), a2 + hstep, voffA);
            PG8_WAIT_V(8); PG8_WAIT_L(0); PG8_BAR; PG8_MMA(0, 0, At, B0); PG8_MMA(0, 1, At, B1); PG8_BAR; PG8_SCHED;
            PG8_LDA(At, 1, 1); PG8_STAGE(PG8_SB(1, 0), b3, voffB); PG8_STAGE(PG8_SB(1, 1), b3 + hstep, voffB); PG8_STAGE(PG8_SA(1, 0), a3, voffA);
            PG8_WAIT_V(8); PG8_WAIT_L(0); PG8_BAR; PG8_MMA(1, 0, At, B0); PG8_MMA(1, 1, At, B1); PG8_BAR; PG8_SCHED;
            } else {
            PG8_LDB(B0, 0, 0); PG8_SCHED; PG8_LDA(At, 0, 0); PG8_STAGE(PG8_SA(1, 1), a1 + hstep, voffA);
            PG8_WAIT_L(8); PG8_BAR; PG8_WAIT_L(0); PG8_MMA(0, 0, At, B0); PG8_BAR; PG8_SCHED;
            PG8_LDB(B1, 0, 1); PG8_STAGE(PG8_SB(0, 0), b2, voffB);
            PG8_BAR; PG8_WAIT_L(0); PG8_MMA(0, 1, At, B1); PG8_BAR;
            PG8_LDA(At, 0, 1); PG8_STAGE(PG8_SA(0, 0), a2, voffA);
            PG8_BAR; PG8_WAIT_L(0); PG8_MMA(1, 0, At, B0); PG8_BAR; PG8_SCHED;
            PG8_STAGE(PG8_SB(0, 1), b2 + hstep, voffB);
            PG8_WAIT_V(6); PG8_BAR; PG8_MMA(1, 1, At, B1); PG8_BAR;
            PG8_LDB(B0, 1, 0); PG8_SCHED; PG8_LDA(At, 1, 0); PG8_STAGE(PG8_SA(0, 1), a2 + hstep, voffA);
            PG8_WAIT_L(8); PG8_BAR; PG8_WAIT_L(0); PG8_MMA(0, 0, At, B0); PG8_BAR; PG8_SCHED;
            PG8_LDB(B1, 1, 1); PG8_STAGE(PG8_SB(1, 0), b3, voffB);
            PG8_BAR; PG8_WAIT_L(0); PG8_MMA(0, 1, At, B1); PG8_BAR;
            PG8_LDA(At, 1, 1); PG8_STAGE(PG8_SA(1, 0), a3, voffA);
            PG8_BAR; PG8_WAIT_L(0); PG8_MMA(1, 0, At, B0); PG8_BAR; PG8_SCHED;
            PG8_STAGE(PG8_SB(1, 1), b3 + hstep, voffB);
            PG8_WAIT_V(6); PG8_BAR; PG8_MMA(1, 1, At, B1); PG8_BAR;
            }
        }
        if constexpr (ALIGN_EPI) { if (wr == 0) PG8_BAR; }
        if constexpr (!Epi::AFTER_DRAIN) { E(acc, cur, wr, wc, fr, fq); S.done(cur); }
        if (!has_next) break;
#pragma unroll
        for (int a = 0; a < 2; ++a)
#pragma unroll
            for (int b = 0; b < 2; ++b)
#pragma unroll
                for (int m = 0; m < 4; ++m)
#pragma unroll
                    for (int n = 0; n < 2; ++n) acc[a][b][m][n] = (f32x4){0.f, 0.f, 0.f, 0.f};
        cur = nxt; cA = nA; cB = nB; ++ui;
        if constexpr (ALIGN_EPI) { if (wr == 1) PG8_BAR; }
    }
    PG8_WAIT_V(0);
    if constexpr (!ALIGN_EPI) { if (wr == 0) PG8_BAR; }
    PG8_BAR;
    if constexpr (Epi::AFTER_DRAIN) { E.fused(acc, cur, wr, wc, fr, fq, lds, wid, lane); S.done(cur); }
#undef PG8_SA
#undef PG8_SB
#undef PG8_STAGE
#undef PG8_LDA
#undef PG8_LDB
#undef PG8_MMA
#undef PG8_WAIT_V
#undef PG8_WAIT_L
#undef PG8_BAR
#undef PG8_SCHED
}
}
#ifndef REP_PHASE
#define REP_PHASE -1
#endif
#define NREP(k) ((k) == REP_PHASE ? 2 : 1)

constexpr int S = 16384, D = 1024, NIN = 4608, FFH = 2816, NGU = 2 * FFH;
constexpr int NHEAD = 12, HD = 64;
constexpr float EPS = 1e-6f;
constexpr int LDS_BYTES = 147456;
constexpr int NPHASE = 10;

#define LAS __attribute__((address_space(3)))
typedef unsigned short bf16_t;
typedef short bf16x8 __attribute__((ext_vector_type(8)));
typedef float f32x4 __attribute__((ext_vector_type(4)));
typedef unsigned u32x4 __attribute__((ext_vector_type(4)));
typedef unsigned u32x2 __attribute__((ext_vector_type(2)));

constexpr size_t MiB = 1u << 20;
constexpr size_t WS_WIN = 0;
constexpr size_t WS_WPA = 9 * MiB;
constexpr size_t WS_WOUT = 10 * MiB;
constexpr size_t WS_WGU = 12 * MiB;
constexpr size_t WS_WD = 23 * MiB;
constexpr size_t WS_WMT = 29 * MiB;
constexpr size_t WS_TAB = 30 * MiB;
constexpr size_t WS_H = 34 * MiB;
constexpr size_t WS_QKV = 66 * MiB;
constexpr size_t WS_U = 138 * MiB;
constexpr size_t WS_GATES = 146 * MiB;
constexpr size_t WS_OG = 210 * MiB;
constexpr size_t WS_LSE = 234 * MiB;
constexpr size_t WS_OA = 235 * MiB;
constexpr size_t WS_H2 = 154 * MiB;
constexpr size_t WS_X1 = 186 * MiB;
constexpr size_t WS_ACT = 66 * MiB;
constexpr size_t WS_CTL = 251 * MiB;
constexpr size_t CTL_ZERO_BYTES = 131072;
constexpr int CW_XBAR = 16384;
constexpr size_t WS_XBUF = 251 * MiB + 131072;
constexpr size_t WS_END = (REP_PHASE >= 0 ? 253 : 252) * MiB;

__device__ __forceinline__ float bf2f(unsigned bits16) { return __builtin_bit_cast(float, bits16 << 16); }
typedef float f32x2_t __attribute__((ext_vector_type(2)));
typedef __bf16 bf16x2_t __attribute__((ext_vector_type(2)));
__device__ __forceinline__ unsigned pk2(float lo, float hi) { f32x2_t v = {lo, hi}; bf16x2_t b = __builtin_convertvector(v, bf16x2_t); return __builtin_bit_cast(unsigned, b); }
__device__ __forceinline__ float wave_sum(float v) {
#pragma unroll
    for (int o = 1; o < 64; o <<= 1) v += __shfl_xor(v, o);
    return v;
}
__device__ __forceinline__ int lane_id_asm() { int l; asm volatile("v_mbcnt_lo_u32_b32 %0, -1, 0\n\tv_mbcnt_hi_u32_b32 %0, -1, %0" : "=v"(l)); return l; }
__device__ __forceinline__ float sigmoidf_(float v) { return __builtin_amdgcn_rcpf(1.0f + __builtin_amdgcn_exp2f(v * -1.4426950408889634f)); }

__host__ __device__ __forceinline__ int in_tile(int pn) { return pn < 8 ? pn + 10 : (pn < 14 ? pn - 8 : (pn == 14 ? 9 : pn - 9)); }
#define OPQ(p) asm volatile("" : "+v"(p))
#define EPI_ROWS_BEGIN _Pragma("unroll") for (int ai = 0; ai < 2; ++ai) { _Pragma("unroll") for (int m = 0; m < 4; ++m) {
#define EPI_ROWS_END(step16, step64) } }
struct EpiIn {
    static constexpr bool PERM = true, AFTER_DRAIN = false, HAS_MID = false;
    bf16_t* qkv; bf16_t* ub; bf16_t* gates; const float* tab;
    __device__ __forceinline__ void operator()(const f32x4 (&acc)[2][2][4][2], const pg8::Unit& u, int wr, int wc, int fr, int fq) const {
        const int pn = in_tile(u.pn);
        const int r0 = u.pm * 256 + wr * 64 + fr;
        if (pn < 6) {
            const int T = pn / 3, g3 = pn - 3 * T, sh = 2 * g3;
            const int rowp0 = ((r0 & ((1 << sh) - 1)) << (14 - sh)) + (r0 >> sh);
            bf16_t* dst = qkv + (((size_t)T * NHEAD + g3 * 4 + wc) * S + rowp0) * HD + 8 * fq;
            const float* tp = tab + ((size_t)r0 * 32 + 8 * fq) * 2;
            const int dstep = (16 >> sh) * HD;
#pragma unroll
            for (int ai = 0; ai < 2; ++ai) {
#pragma unroll
                for (int m = 0; m < 4; ++m) {
                    u32x4 w1, w2;
#pragma unroll
                    for (int n = 0; n < 2; ++n) {
                        const f32x4 cs0 = *(const f32x4*)(tp + 8 * n), cs1 = *(const f32x4*)(tp + 8 * n + 4);
                        const f32x4 a = acc[ai][0][m][n], b = acc[ai][1][m][n];
                        const float o10 = a[0] * cs0[0] - b[0] * cs0[1], o20 = b[0] * cs0[0] + a[0] * cs0[1];
                        const float o11 = a[1] * cs0[2] - b[1] * cs0[3], o21 = b[1] * cs0[2] + a[1] * cs0[3];
                        const float o12 = a[2] * cs1[0] - b[2] * cs1[1], o22 = b[2] * cs1[0] + a[2] * cs1[1];
                        const float o13 = a[3] * cs1[2] - b[3] * cs1[3], o23 = b[3] * cs1[2] + a[3] * cs1[3];
                        w1[2 * n] = pk2(o10, o11); w1[2 * n + 1] = pk2(o12, o13); w2[2 * n] = pk2(o20, o21); w2[2 * n + 1] = pk2(o22, o23);
                    }
                    *(u32x4*)dst = w1; *(u32x4*)(dst + 32) = w2;
                    dst += dstep; tp += 16 * 64; OPQ(dst); OPQ(tp);
                }
                dst += 4 * dstep; tp += 64 * 64; OPQ(dst); OPQ(tp);
            }
        } else if (pn < 9) {
            const int g3 = pn - 6, sh = 2 * g3;
            const int rowp0 = ((r0 & ((1 << sh) - 1)) << (14 - sh)) + (r0 >> sh);
            bf16_t* dst = qkv + (((size_t)2 * NHEAD + g3 * 4 + (wc >> 1)) * S + rowp0) * HD + 32 * (wc & 1) + 8 * fq;
            const int dstep = (16 >> sh) * HD;
#pragma unroll
            for (int ai = 0; ai < 2; ++ai) {
#pragma unroll
                for (int m = 0; m < 4; ++m) {
#pragma unroll
                    for (int bj = 0; bj < 2; ++bj) { const f32x4 a0 = acc[ai][bj][m][0], a1 = acc[ai][bj][m][1];
                        u32x4 wv; wv.x = pk2(a0[0], a0[1]); wv.y = pk2(a0[2], a0[3]); wv.z = pk2(a1[0], a1[1]); wv.w = pk2(a1[2], a1[3]); *(u32x4*)(dst + (size_t)bj * 2 * S * HD) = wv; }
                    dst += dstep; OPQ(dst);
                }
                dst += 4 * dstep; OPQ(dst);
            }
        } else if (pn == 9) {
            bf16_t* dst = ub + (size_t)r0 * 256 + 32 * wc + 8 * fq;
#pragma unroll
            for (int ai = 0; ai < 2; ++ai) {
#pragma unroll
                for (int m = 0; m < 4; ++m) {
#pragma unroll
                    for (int bj = 0; bj < 2; ++bj) { const f32x4 a0 = acc[ai][bj][m][0], a1 = acc[ai][bj][m][1];
                        u32x4 wv; wv.x = pk2(a0[0], a0[1]); wv.y = pk2(a0[2], a0[3]); wv.z = pk2(a1[0], a1[1]); wv.w = pk2(a1[2], a1[3]); *(u32x4*)(dst + 128 * bj) = wv; }
                    dst += 16 * 256; OPQ(dst);
                }
                dst += 64 * 256; OPQ(dst);
            }
        } else {
            const int tg = pn - 10, wid = wr * 4 + wc, lane = fq * 16 + fr;
            unsigned char* dst = (unsigned char*)gates + ((size_t)(u.pm * 8 + tg) * 2) * 65536 + (wid * 64 + lane) * 16;
#pragma unroll
            for (int ai = 0; ai < 2; ++ai)
#pragma unroll
                for (int m = 0; m < 4; ++m) {
                    u32x4 w0, w1;
#pragma unroll
                    for (int n = 0; n < 2; ++n) {
                        const f32x4 a = acc[ai][0][m][n], b = acc[ai][1][m][n];
                        f32x4 ra, sp;
#pragma unroll
                        for (int j = 0; j < 4; ++j) { const float pa = 1.0f + __builtin_amdgcn_exp2f(fminf(a[j] * -1.4426950408889634f, 60.0f)), pb = 1.0f + __builtin_amdgcn_exp2f(fminf(b[j] * -1.4426950408889634f, 60.0f));
                            const float rr = __builtin_amdgcn_rcpf(pa * pb);
                            sp[j] = pa * rr; ra[j] = pb * pb * rr; }
                        w0[2 * n] = pk2(ra[0], ra[1]); w0[2 * n + 1] = pk2(ra[2], ra[3]); w1[2 * n] = pk2(sp[0], sp[1]); w1[2 * n + 1] = pk2(sp[2], sp[3]);
                    }
                    *(u32x4*)dst = w0; *(u32x4*)(dst + 65536) = w1;
                    dst += 8192; OPQ(dst);
                }
        }
    }
};

struct EpiGate2 {
    static constexpr bool PERM = true, AFTER_DRAIN = false, HAS_MID = true;
    const bf16_t* gates; bf16_t* merged;
    __device__ __forceinline__ void mid(f32x4 (&acc)[2][2][4][2], const pg8::Unit& u, int wr, int wc, int fr, int fq) const {
        const int wid = wr * 4 + wc, lane = fq * 16 + fr;
#pragma unroll
        for (int bj = 0; bj < 2; ++bj) {
            const unsigned char* gp = (const unsigned char*)gates + ((size_t)(u.pm * 8 + 2 * u.pn + bj) * 2) * 65536 + (wid * 64 + lane) * 16;
#pragma unroll
            for (int ai = 0; ai < 2; ++ai)
#pragma unroll
                for (int m = 0; m < 4; ++m) {
                    const u32x4 ga = *(const u32x4*)gp;
#pragma unroll
                    for (int n = 0; n < 2; ++n) { f32x4 ra; ra[0] = bf2f(ga[2 * n] & 0xffffu); ra[1] = bf2f(ga[2 * n] >> 16); ra[2] = bf2f(ga[2 * n + 1] & 0xffffu); ra[3] = bf2f(ga[2 * n + 1] >> 16);
                        acc[ai][bj][m][n] = acc[ai][bj][m][n] * ra; }
                    gp += 8192; OPQ(gp);
                }
        }
    }
    __device__ __forceinline__ void operator()(const f32x4 (&acc)[2][2][4][2], const pg8::Unit& u, int wr, int wc, int fr, int fq) const {
        const int wid = wr * 4 + wc, lane = fq * 16 + fr;
        const int r0 = u.pm * 256 + wr * 64 + fr, c0 = u.pn * 256 + 32 * wc + 8 * fq;
#pragma unroll
        for (int bj = 0; bj < 2; ++bj) {
            const unsigned char* gp = (const unsigned char*)gates + ((size_t)(u.pm * 8 + 2 * u.pn + bj) * 2 + 1) * 65536 + (wid * 64 + lane) * 16;
            bf16_t* mp = merged + (size_t)r0 * D + c0 + 128 * bj;
#pragma unroll
            for (int ai = 0; ai < 2; ++ai) {
#pragma unroll
                for (int m = 0; m < 4; ++m) {
                    const u32x4 gw = *(const u32x4*)gp;
                    u32x4 wv;
#pragma unroll
                    for (int n = 0; n < 2; ++n) { f32x4 g; g[0] = bf2f(gw[2 * n] & 0xffffu); g[1] = bf2f(gw[2 * n] >> 16); g[2] = bf2f(gw[2 * n + 1] & 0xffffu); g[3] = bf2f(gw[2 * n + 1] >> 16);
                        const f32x4 o = acc[ai][bj][m][n] * g; wv[2 * n] = pk2(o[0], o[1]); wv[2 * n + 1] = pk2(o[2], o[3]); }
                    *(u32x4*)mp = wv;
                    gp += 8192; OPQ(gp);
                    mp += 16 * D; OPQ(mp);
                }
                mp += 64 * D; OPQ(mp);
            }
        }
    }
};

struct EpiF32 {
    static constexpr bool PERM = false, AFTER_DRAIN = false, HAS_MID = false;
    float* out; int ldc;
    __device__ __forceinline__ void operator()(const f32x4 (&acc)[2][2][4][2], const pg8::Unit& u, int wr, int wc, int fr, int fq) const {
        float* op = out + (size_t)(u.pm * 256 + wr * 64 + fr) * ldc + u.pn * 256 + 32 * wc + 4 * fq;
#pragma unroll
        for (int ai = 0; ai < 2; ++ai) {
#pragma unroll
            for (int m = 0; m < 4; ++m) {
#pragma unroll
                for (int bj = 0; bj < 2; ++bj)
#pragma unroll
                    for (int n = 0; n < 2; ++n) *(f32x4*)(op + 128 * bj + 16 * n) = acc[ai][bj][m][n];
                op += 16 * (size_t)ldc; OPQ(op);
            }
            op += 64 * (size_t)ldc; OPQ(op);
        }
    }
};

struct EpiSwiglu {
    static constexpr bool PERM = true, AFTER_DRAIN = false, HAS_MID = false;
    bf16_t* act;
    __device__ __forceinline__ void operator()(const f32x4 (&acc)[2][2][4][2], const pg8::Unit& u, int wr, int wc, int fr, int fq) const {
        bf16_t* op = act + (size_t)(u.pm * 256 + wr * 64 + fr) * FFH + u.pn * 128 + 32 * wc + 8 * fq;
#pragma unroll
        for (int ai = 0; ai < 2; ++ai) {
#pragma unroll
            for (int m = 0; m < 4; ++m) {
                u32x4 wv;
#pragma unroll
                for (int n = 0; n < 2; ++n) {
                    const f32x4 a = acc[ai][0][m][n], b = acc[ai][1][m][n];
                    f32x4 o;
#pragma unroll
                    for (int j = 0; j < 4; ++j) o[j] = a[j] * sigmoidf_(a[j]) * b[j];
                    wv[2 * n] = pk2(o[0], o[1]); wv[2 * n + 1] = pk2(o[2], o[3]);
                }
                __builtin_nontemporal_store(wv, (u32x4*)op);
                op += 16 * FFH; OPQ(op);
            }
            op += 64 * FFH; OPQ(op);
        }
    }
};

struct RowStats {
    unsigned* xbuf;
    unsigned* cnt;
    __device__ __forceinline__ void run(const f32x4 (&v)[2][2][4][2], const pg8::Unit& u, int wr, int wc, int fr, int fq, LAS unsigned char* lds, int wid, int lane) const {
        LAS float* P = (LAS float*)lds;
        LAS float* Sg = (LAS float*)(lds + 8192);
#pragma unroll
        for (int ai = 0; ai < 2; ++ai)
#pragma unroll
            for (int m = 0; m < 4; ++m) {
                float q = 0.f;
#pragma unroll
                for (int bj = 0; bj < 2; ++bj)
#pragma unroll
                    for (int n = 0; n < 2; ++n) { const f32x4 d = v[ai][bj][m][n]; q += (d[0] * d[0] + d[1] * d[1]) + (d[2] * d[2] + d[3] * d[3]); }
                q += __shfl_xor(q, 16); q += __shfl_xor(q, 32);
                if (fq == 0) P[(ai * 128 + wr * 64 + m * 16 + fr) * 4 + wc] = q;
            }
        asm volatile("s_waitcnt lgkmcnt(0)" ::: "memory"); __builtin_amdgcn_s_barrier(); asm volatile("" ::: "memory");
        const int row = wid * 32 + (lane & 31);
        if (lane < 32) {
            const float tot = (P[row * 4 + 0] + P[row * 4 + 1]) + (P[row * 4 + 2] + P[row * 4 + 3]);
            __hip_atomic_store(xbuf + ((size_t)(u.pm * 256 + row) * 4 + u.pn), __builtin_bit_cast(unsigned, tot), __ATOMIC_RELAXED, __HIP_MEMORY_SCOPE_AGENT);
        }
        asm volatile("s_waitcnt vmcnt(0)" ::: "memory");
        if (lane == 0) __hip_atomic_fetch_add(cnt + 64 * u.pm, 1u, __ATOMIC_RELAXED, __HIP_MEMORY_SCOPE_AGENT);
        if (wid == 0) {
            unsigned spins = 0;
            while ((unsigned)__builtin_amdgcn_readfirstlane(__hip_atomic_load(cnt + 64 * u.pm, __ATOMIC_RELAXED, __HIP_MEMORY_SCOPE_AGENT)) < 32u) {
                __builtin_amdgcn_s_sleep(2); if (++spins > (1u << 22)) break; }
            __builtin_amdgcn_fence(__ATOMIC_ACQUIRE, "agent");
        }
        asm volatile("s_waitcnt vmcnt(0) lgkmcnt(0)" ::: "memory"); __builtin_amdgcn_s_barrier(); asm volatile("" ::: "memory");
        if (lane < 32) {
            const unsigned* slot = xbuf + (size_t)(u.pm * 256 + row) * 4; float t[4];
#pragma unroll
            for (int k = 0; k < 4; ++k) t[k] = __builtin_bit_cast(float, __hip_atomic_load(slot + k, __ATOMIC_RELAXED, __HIP_MEMORY_SCOPE_AGENT));
            Sg[row] = 1.0f / sqrtf(((t[0] + t[1]) + (t[2] + t[3])) * (1.0f / D) + EPS);
        }
        asm volatile("s_waitcnt lgkmcnt(0)" ::: "memory"); __builtin_amdgcn_s_barrier(); asm volatile("" ::: "memory");
    }
};
struct EpiRmsResRms {
    static constexpr bool PERM = true, AFTER_DRAIN = true, HAS_MID = false;
    const float* base; bf16_t* x1b; bf16_t* xn; const float* g1; const float* g2; RowStats st1, st2;
    __device__ __forceinline__ void fused(f32x4 (&acc)[2][2][4][2], const pg8::Unit& u, int wr, int wc, int fr, int fq, LAS unsigned char* lds, int wid, int lane) const {
        const LAS float* Sg = (const LAS float*)(lds + 8192);
        const int col0 = u.pn * 256 + wc * 32 + 8 * fq;
        const float* bp = base + (size_t)(u.pm * 256 + wr * 64 + fr) * D + col0;
        f32x4 pre[4][2][2];
#pragma unroll
        for (int m = 0; m < 4; ++m)
#pragma unroll
            for (int bj = 0; bj < 2; ++bj)
#pragma unroll
                for (int n = 0; n < 2; ++n) pre[m][bj][n] = *(const f32x4*)(bp + (size_t)m * 16 * D + bj * 128 + n * 4);
        st1.run(acc, u, wr, wc, fr, fq, lds, wid, lane);
        {
            f32x4 gv[2][2];
#pragma unroll
            for (int bj = 0; bj < 2; ++bj)
#pragma unroll
                for (int n = 0; n < 2; ++n) gv[bj][n] = *(const f32x4*)(g1 + col0 + bj * 128 + n * 4);
#pragma unroll
            for (int ai = 0; ai < 2; ++ai) {
#pragma unroll
                for (int m = 0; m < 4; ++m) {
                    const float r1 = Sg[ai * 128 + wr * 64 + m * 16 + fr];
#pragma unroll
                    for (int bj = 0; bj < 2; ++bj)
#pragma unroll
                        for (int n = 0; n < 2; ++n) { const f32x4 bs = pre[m][bj][n]; acc[ai][bj][m][n] = bs + acc[ai][bj][m][n] * r1 * gv[bj][n]; }
                    if (ai == 0) {
#pragma unroll
                        for (int bj = 0; bj < 2; ++bj)
#pragma unroll
                            for (int n = 0; n < 2; ++n) pre[m][bj][n] = *(const f32x4*)(bp + (size_t)128 * D + bj * 128 + n * 4);
                    }
                    asm volatile("" : "+v"(acc[ai][0][m][0]), "+v"(acc[ai][0][m][1]), "+v"(acc[ai][1][m][0]), "+v"(acc[ai][1][m][1]));
                    bp += 16 * D; OPQ(bp);
                    if (m & 1) asm volatile("" ::: "memory");
                }
                bp += 64 * D; OPQ(bp);
            }
        }
        st2.run(acc, u, wr, wc, fr, fq, lds, wid, lane);
        {
            f32x4 gv[2][2];
#pragma unroll
            for (int bj = 0; bj < 2; ++bj)
#pragma unroll
                for (int n = 0; n < 2; ++n) gv[bj][n] = *(const f32x4*)(g2 + col0 + bj * 128 + n * 4);
            bf16_t* op = x1b + (size_t)(u.pm * 256 + wr * 64 + fr) * D + col0; bf16_t* xp = xn + (size_t)(u.pm * 256 + wr * 64 + fr) * D + col0;
#pragma unroll
            for (int ai = 0; ai < 2; ++ai) {
#pragma unroll
                for (int m = 0; m < 4; ++m) {
                    const float r2 = Sg[ai * 128 + wr * 64 + m * 16 + fr];
#pragma unroll
                    for (int bj = 0; bj < 2; ++bj) { u32x4 wx, wv;
#pragma unroll
                        for (int n = 0; n < 2; ++n) { const f32x4 x1 = acc[ai][bj][m][n]; wx[2 * n] = pk2(x1[0], x1[1]); wx[2 * n + 1] = pk2(x1[2], x1[3]);
                            const f32x4 o = x1 * r2 * gv[bj][n]; wv[2 * n] = pk2(o[0], o[1]); wv[2 * n + 1] = pk2(o[2], o[3]); }
                        *(u32x4*)(op + bj * 128) = wx; *(u32x4*)(xp + bj * 128) = wv; }
                    op += 16 * D; xp += 16 * D; OPQ(op); OPQ(xp);
                }
                op += 64 * D; xp += 64 * D; OPQ(op); OPQ(xp);
            }
        }
    }
};
struct EpiRmsRes {
    static constexpr bool PERM = true, AFTER_DRAIN = true, HAS_MID = false;
    const bf16_t* x1b; float* out; const float* g1; RowStats st;
    __device__ __forceinline__ void fused(f32x4 (&acc)[2][2][4][2], const pg8::Unit& u, int wr, int wc, int fr, int fq, LAS unsigned char* lds, int wid, int lane) const {
        const LAS float* Sg = (const LAS float*)(lds + 8192);
        const int col0 = u.pn * 256 + wc * 32 + 8 * fq;
        const bf16_t* bp = x1b + (size_t)(u.pm * 256 + wr * 64 + fr) * D + col0; float* op = out + (size_t)(u.pm * 256 + wr * 64 + fr) * D + col0;
        u32x4 pre[2][4][2];
#pragma unroll
        for (int ai = 0; ai < 2; ++ai)
#pragma unroll
            for (int m = 0; m < 4; ++m)
#pragma unroll
                for (int bj = 0; bj < 2; ++bj) pre[ai][m][bj] = *(const u32x4*)(bp + (size_t)(ai * 128 + m * 16) * D + bj * 128);
        st.run(acc, u, wr, wc, fr, fq, lds, wid, lane);
        f32x4 gv[2][2];
#pragma unroll
        for (int bj = 0; bj < 2; ++bj)
#pragma unroll
            for (int n = 0; n < 2; ++n) gv[bj][n] = *(const f32x4*)(g1 + col0 + bj * 128 + n * 4);
#pragma unroll
        for (int ai = 0; ai < 2; ++ai) {
#pragma unroll
            for (int m = 0; m < 4; ++m) {
                const float r1 = Sg[ai * 128 + wr * 64 + m * 16 + fr];
#pragma unroll
                for (int bj = 0; bj < 2; ++bj)
#pragma unroll
                    for (int n = 0; n < 2; ++n) { const unsigned px = pre[ai][m][bj][2 * n], py = pre[ai][m][bj][2 * n + 1]; f32x4 bs; bs[0] = bf2f(px & 0xffffu); bs[1] = bf2f(px >> 16); bs[2] = bf2f(py & 0xffffu); bs[3] = bf2f(py >> 16);
                        *(f32x4*)(op + bj * 128 + n * 4) = bs + acc[ai][bj][m][n] * r1 * gv[bj][n]; }
                op += 16 * D; OPQ(op);
            }
            op += 64 * D; OPQ(op);
        }
    }
};

template <int MAP> __device__ __forceinline__ int src_col(int s) {
    if (MAP == 1) s = in_tile(s >> 8) * 256 + (s & 255);
    if (MAP == 1) { if (s < 1536) { const int bj = (s >> 7) & 1, wc = (s >> 5) & 3, rest = s & 31; return (s & ~255) + 64 * wc + 32 * bj + rest; }
                    if (s >= 2560) { const int tg = (s - 2560) >> 8, bj = (s >> 7) & 1, cc = s & 127; return 2560 + bj * 1024 + 128 * tg + cc; } return s; }
    if (MAP == 2) { const int pn = s >> 8, bj = (s >> 7) & 1, cc = s & 127; return bj * FFH + 128 * pn + cc; }
    return s;
}
template <int MAP> __device__ __forceinline__ void transpose_item(const float* W, int K, int N, bf16_t* WT, LAS float* scr, int item, int lane, int ldk = 0) {
    const int nblk = N / 32, kb = item / nblk, nb = item % nblk, k0 = 64 * kb, n0 = 32 * nb;
    const int sc = src_col<MAP>(n0 + (lane & 31));
    float tv[32];
#pragma unroll
    for (int i = 0; i < 32; ++i) tv[i] = W[(size_t)(k0 + 2 * i + (lane >> 5)) * N + sc];
#pragma unroll
    for (int i = 0; i < 32; ++i) scr[(2 * i + (lane >> 5)) * 33 + (lane & 31)] = tv[i];
    asm volatile("s_waitcnt lgkmcnt(0)" ::: "memory");
    const int c = lane & 7;
#pragma unroll
    for (int j = 0; j < 4; ++j) { const int n = (lane >> 3) + 8 * j; const LAS float* s = scr + (8 * c) * 33 + n;
        u32x4 o; o.x = pk2(s[0 * 33], s[1 * 33]); o.y = pk2(s[2 * 33], s[3 * 33]); o.z = pk2(s[4 * 33], s[5 * 33]); o.w = pk2(s[6 * 33], s[7 * 33]);
        *(u32x4*)(WT + (size_t)(n0 + n) * (ldk ? ldk : K) + k0 + 8 * c) = o; }
    asm volatile("s_waitcnt lgkmcnt(0)" ::: "memory");
}

template <int MAP> __device__ __forceinline__ void transpose_sub(const float* W, int K, int N, bf16_t* WT, LAS float* scr, int item, int sub, int lane) {
    const int nblk = N / 32, kb = item / nblk, nb = item % nblk, k0 = 64 * kb + 8 * sub, n0 = 32 * nb;
    const int sc = src_col<MAP>(n0 + (lane & 31));
    float tv[4];
#pragma unroll
    for (int i = 0; i < 4; ++i) tv[i] = W[(size_t)(k0 + 2 * i + (lane >> 5)) * N + sc];
#pragma unroll
    for (int i = 0; i < 4; ++i) scr[(2 * i + (lane >> 5)) * 33 + (lane & 31)] = tv[i];
    asm volatile("s_waitcnt lgkmcnt(0)" ::: "memory");
    if (lane < 32) { const LAS float* sp = scr + lane;
        u32x4 o; o.x = pk2(sp[0 * 33], sp[1 * 33]); o.y = pk2(sp[2 * 33], sp[3 * 33]); o.z = pk2(sp[4 * 33], sp[5 * 33]); o.w = pk2(sp[6 * 33], sp[7 * 33]);
        *(u32x4*)(WT + (size_t)(n0 + lane) * K + k0) = o; }
    asm volatile("s_waitcnt lgkmcnt(0)" ::: "memory");
}

template <int W> __device__ __forceinline__ void pool_unit(const bf16_t* Ub, const bf16_t* WmT, const float* pool_scale, bf16_t* YP, int tt, int g, int c, int q) {
    const int t = 16 * tt + c;
    const int cnt = (t + 1 < W) ? t + 1 : W; const float rc = 1.0f / (float)cnt;
    bf16x8 zf[2];
#pragma unroll
    for (int kc = 0; kc < 2; ++kc) {
        const bf16_t* up = Ub + (size_t)t * 256 + g * 64 + 32 * kc + 8 * q;
        u32x4 v[W];
#pragma unroll
        for (int i = 0; i < W; ++i) { const int ti = (i <= t) ? i : 0; v[i] = *(const u32x4*)(up - (size_t)ti * 256); }
        float sum[8];
#pragma unroll
        for (int e = 0; e < 8; ++e) sum[e] = 0.f;
#pragma unroll
        for (int i = 0; i < W; ++i) { const float wgt = (i <= t) ? 1.0f : 0.0f;
#pragma unroll
            for (int e = 0; e < 4; ++e) { sum[2 * e] += wgt * bf2f(v[i][e] & 0xffffu); sum[2 * e + 1] += wgt * bf2f(v[i][e] >> 16); } }
        u32x4 zw;
#pragma unroll
        for (int e = 0; e < 4; ++e) zw[e] = pk2(sum[2 * e] * rc - bf2f(v[0][e] & 0xffffu), sum[2 * e + 1] * rc - bf2f(v[0][e] >> 16));
        zf[kc] = __builtin_bit_cast(bf16x8, zw);
    }
#pragma unroll
    for (int dt = 0; dt < 4; ++dt) {
        const bf16_t* wp = WmT + (size_t)g * 4096 + (16 * dt + c) * 64 + 8 * q;
        const bf16x8 a0 = *(const bf16x8*)wp, a1 = *(const bf16x8*)(wp + 32);
        f32x4 a = (f32x4){0.f, 0.f, 0.f, 0.f};
        a = __builtin_amdgcn_mfma_f32_16x16x32_bf16(a0, zf[0], a, 0, 0, 0);
        a = __builtin_amdgcn_mfma_f32_16x16x32_bf16(a1, zf[1], a, 0, 0, 0);
        const f32x4 scl = *(const f32x4*)(pool_scale + g * 64 + 16 * dt + 4 * q);
        u32x2 wv; wv.x = pk2(a[0] * scl[0], a[1] * scl[1]); wv.y = pk2(a[2] * scl[2], a[3] * scl[3]);
        *(u32x2*)(YP + (size_t)t * 512 + 256 + g * 64 + 16 * dt + 4 * q) = wv;
    }
}

#define XB_TMO      128
#define XB_XCNT(j)  (256  + 64 * (j))
#define XB_XSUB(j)  (1280 + 64 * (j))
#define XB_XGEN(j)  (2304 + 64 * (j))
#define XB_TOP      3328
#define XB_TOPGEN   3392
#define XCD_BAR_WORDS 3456
#define XB_SPIN_CAP (1u << 18)

__device__ __forceinline__ unsigned xb_ld(unsigned* p)              { return __hip_atomic_load(p, __ATOMIC_RELAXED, __HIP_MEMORY_SCOPE_AGENT); }
__device__ __forceinline__ unsigned xb_add(unsigned* p, unsigned v) { return __hip_atomic_fetch_add(p, v, __ATOMIC_RELAXED, __HIP_MEMORY_SCOPE_AGENT); }
__device__ __forceinline__ unsigned xb_xcc_id() { return (unsigned)__builtin_amdgcn_s_getreg((3 << 11) | 20) & 0xFu; }
#define XB_SPIN(cond, bar) do { unsigned _sp = 0; while (cond) { __builtin_amdgcn_s_sleep(1); \
    if ((++_sp & 255u) == 0u) { if (xb_ld(&(bar)[XB_TMO])) break; if (_sp > XB_SPIN_CAP) { atomicAdd(&(bar)[XB_TMO], 1u); break; } } } } while (0)

struct XcdBarrier {
    unsigned* bar; unsigned x;
    volatile LAS unsigned* st;
};

__device__ __forceinline__ XcdBarrier xcd_barrier_post(unsigned* bar, volatile LAS unsigned* st) {
    XcdBarrier b; b.bar = bar; b.x = xb_xcc_id(); b.st = st;
    if (threadIdx.x == 0) (void)xb_add(&bar[XB_XCNT(b.x)], 1u);
    return b;
}
__device__ __forceinline__ void xcd_barrier_complete(unsigned* bar, unsigned x, unsigned& nloc, unsigned& nx) {
    const unsigned G = gridDim.x * gridDim.y * gridDim.z;
    unsigned sum, cnt, mine, sp = 0u;
    for (;;) {
        sum = 0u; cnt = 0u; mine = 0u;
#pragma unroll
        for (unsigned j = 0; j < 16; ++j) { const unsigned c = xb_ld(&bar[XB_XCNT(j)]); sum += c; cnt += (c > 0u) ? 1u : 0u; mine = (j == x) ? c : mine; }
        if (sum == G) break;
        __builtin_amdgcn_s_sleep(1);
        if ((++sp & 255u) == 0u) { if (xb_ld(&bar[XB_TMO])) break; if (sp > XB_SPIN_CAP) { atomicAdd(&bar[XB_TMO], 1u); break; } }
    }
    nloc = mine > 0u ? mine : 1u; nx = cnt > 0u ? cnt : 1u;
}

__device__ __forceinline__ void xcd_barrier(const XcdBarrier& b) {
    asm volatile("s_waitcnt vmcnt(0)" ::: "memory");
    __syncthreads();
    if (threadIdx.x == 0) {
        unsigned* bar = b.bar;
        __builtin_amdgcn_s_waitcnt(0);
        unsigned nloc = b.st[0], nx = b.st[1];
        if (nloc == 0u) { xcd_barrier_complete(bar, b.x, nloc, nx); b.st[0] = nloc; b.st[1] = nx; }
        const unsigned old = xb_add(&bar[XB_XSUB(b.x)], 1u);
        const unsigned gen = old / nloc;
        if (old + 1u == (gen + 1u) * nloc) {
            __builtin_amdgcn_fence(__ATOMIC_RELEASE, "agent");
            asm volatile("s_waitcnt vmcnt(0)" ::: "memory");
            const unsigned og = xb_add(&bar[XB_TOP], 1u);
            const unsigned tg = og / nx;
            if (og + 1u == (tg + 1u) * nx) xb_add(&bar[XB_TOPGEN], 1u);
            else XB_SPIN(xb_ld(&bar[XB_TOPGEN]) == tg, bar);
            __builtin_amdgcn_fence(__ATOMIC_ACQUIRE, "agent");
            xb_add(&bar[XB_XGEN(b.x)], 1u);
            asm volatile("s_waitcnt vmcnt(0)" ::: "memory");
        } else {
            XB_SPIN(xb_ld(&bar[XB_XGEN(b.x)]) == gen, bar);
            __builtin_amdgcn_fence(__ATOMIC_ACQUIRE, "agent");
            asm volatile("s_waitcnt vmcnt(0)" ::: "memory");
        }
    }
    __syncthreads();
}


struct Args { const float* in[13]; float* out; unsigned char* ws; float invf[32]; int lo, hi; };

__global__ void __launch_bounds__(512, 2) fwd_mega(Args args) {
    extern __shared__ __attribute__((aligned(16))) unsigned char lds_raw[];
    LAS unsigned char* lds = (LAS unsigned char*)lds_raw;
    cg::grid_group grid = cg::this_grid();
    const int wave = __builtin_amdgcn_readfirstlane((int)threadIdx.x >> 6);
#define LANE_TID() const int lane = lane_id_asm(), tid = wave * 64 + lane
    const int G = gridDim.x, gw = blockIdx.x * 8 + wave, NGW = G * 8;
    const int lo = args.lo, hi = args.hi;
    volatile LAS unsigned* MISC = (volatile LAS unsigned*)(lds + 131072);
    if (threadIdx.x < 2) MISC[threadIdx.x] = 0u;
    __syncthreads();
    if (hi > NPHASE + 1) grid.sync();
    const XcdBarrier xbar = xcd_barrier_post((unsigned*)(args.ws + WS_CTL) + CW_XBAR, MISC);
#define IN(k) (lo <= (k) && (k) < hi)
#define WSP(T, off) ((T*)(args.ws + (off)))
#define SEAM(k) do { if (IN(k) && IN((k) + 1)) xcd_barrier(xbar); } while (0)

    for (int rep_ = 0; rep_ < NREP(0); ++rep_) { if (rep_) xcd_barrier(xbar);
    if (IN(0)) {
        LANE_TID(); (void)tid;
        LAS float* scr = (LAS float*)(lds + wave * 16384);
        const float* x = args.in[0]; const float* g_pre_mix = args.in[1]; const float* w_in = args.in[2];
        bf16_t* WinT = WSP(bf16_t, WS_WIN); float* tab = WSP(float, WS_TAB); bf16_t* Hb = WSP(bf16_t, WS_H);
        constexpr int I_IN = (D / 64) * (NIN / 32);
        {
            const int nfull = (I_IN / NGW) * NGW;
            for (int it = gw; it < nfull; it += NGW) transpose_item<1>(w_in, D, NIN, WinT, scr, it, lane);
            for (int it = nfull + (int)blockIdx.x; it < I_IN; it += G) transpose_sub<1>(w_in, D, NIN, WinT, scr, it, wave, lane);
        }
        for (int e = blockIdx.x * 512 + tid; e < S * 32; e += G * 512) {
            const int pos = e >> 5, f = e & 31;
            const float ang = (float)pos * args.invf[f];
            const double rev = (double)ang * 0.15915494309189535;
            const float fr = (float)(rev - floor(rev));
            tab[2 * e] = __builtin_amdgcn_cosf(fr); tab[2 * e + 1] = __builtin_amdgcn_sinf(fr);
        }
        {
            f32x4 gq[4];
#pragma unroll
            for (int j = 0; j < 4; ++j) gq[j] = ((const f32x4*)g_pre_mix)[lane + 64 * j];
            for (int m = gw; m < S; m += 2 * NGW) {
                const int m2 = m + NGW;
                const f32x4* xa = (const f32x4*)(x + (size_t)m * D) + lane; const f32x4* xb = (const f32x4*)(x + (size_t)(m2 < S ? m2 : m) * D) + lane;
                f32x4 va[4], vb[4]; float sa = 0.f, sb = 0.f;
#pragma unroll
                for (int j = 0; j < 4; ++j) { va[j] = xa[64 * j]; vb[j] = xb[64 * j]; }
#pragma unroll
                for (int j = 0; j < 4; ++j) { sa += (va[j][0] * va[j][0] + va[j][1] * va[j][1]) + (va[j][2] * va[j][2] + va[j][3] * va[j][3]); sb += (vb[j][0] * vb[j][0] + vb[j][1] * vb[j][1]) + (vb[j][2] * vb[j][2] + vb[j][3] * vb[j][3]); }
                const float ra = 1.0f / sqrtf(wave_sum(sa) * (1.0f / D) + EPS), rb = 1.0f / sqrtf(wave_sum(sb) * (1.0f / D) + EPS);
                u32x2* oa = (u32x2*)(Hb + (size_t)m * D) + lane; u32x2* ob = (u32x2*)(Hb + (size_t)m2 * D) + lane;
#pragma unroll
                for (int j = 0; j < 4; ++j) { u32x2 w; w.x = pk2(va[j][0] * ra * gq[j][0], va[j][1] * ra * gq[j][1]); w.y = pk2(va[j][2] * ra * gq[j][2], va[j][3] * ra * gq[j][3]); oa[64 * j] = w; }
                if (m2 < S) {
#pragma unroll
                    for (int j = 0; j < 4; ++j) { u32x2 w; w.x = pk2(vb[j][0] * rb * gq[j][0], vb[j][1] * rb * gq[j][1]); w.y = pk2(vb[j][2] * rb * gq[j][2], vb[j][3] * rb * gq[j][3]); ob[64 * j] = w; }
                }
            }
        }
    } }
    SEAM(0);

    for (int rep_ = 0; rep_ < NREP(1); ++rep_) { if (rep_) xcd_barrier(xbar);
    if (IN(1)) {
        LANE_TID(); (void)tid;
        pg8::Gemm g{WSP(bf16_t, WS_H), WSP(bf16_t, WS_WIN), S, NIN, D}; pg8::StaticOrder So; So.init(S, NIN, G, (int)blockIdx.x);
        EpiIn E{WSP(bf16_t, WS_QKV), WSP(bf16_t, WS_U), WSP(bf16_t, WS_GATES), WSP(float, WS_TAB)};
        pg8::gemm_phase<EpiIn, pg8::StaticOrder, true, true>(lds, g, So, E, wave, lane);
        {
            const int nwg = (S / 256) * (NIN / 256), rem = nwg % G;
            const bool helper = (rem == 0) || ((int)blockIdx.x >= rem);
            if (helper) {
                const int nh = (rem == 0) ? G : G - rem, hid = (rem == 0) ? (int)blockIdx.x : (int)blockIdx.x - rem;
                const float* w_mix = args.in[3]; const float* w_pa = args.in[5]; const float* w_pp = args.in[6]; const float* w_out = args.in[7]; const float* w_gu = args.in[10]; const float* w_down = args.in[11];
                bf16_t* WpaT = WSP(bf16_t, WS_WPA); bf16_t* WoutT = WSP(bf16_t, WS_WOUT); bf16_t* WguT = WSP(bf16_t, WS_WGU); bf16_t* WdT = WSP(bf16_t, WS_WD); bf16_t* WmT = WSP(bf16_t, WS_WMT);
                LAS float* scr = (LAS float*)(lds + wave * 16384);
                constexpr int I_PA = (256 / 64) * (D / 32), I_OUT = (D / 64) * (D / 32), I_GU = (D / 64) * (NGU / 32), I_DN = (FFH / 64) * (D / 32), I_MX = 4 * 2;
                constexpr int NDEF = 2 * I_PA + I_OUT + I_GU + I_DN + I_MX;
                for (int it = hid * 8 + wave; it < NDEF; it += nh * 8) {
                    int r = it;
                    if (r < I_MX) { const int gg = r >> 1; transpose_item<0>(w_mix + gg * 4096, 64, 64, WmT + gg * 4096, scr, r & 1, lane); continue; } r -= I_MX;
                    if (r < I_PA) { transpose_item<0>(w_pa, 256, D, WpaT, scr, r, lane, 512); continue; } r -= I_PA;
                    if (r < I_PA) { transpose_item<0>(w_pp, 256, D, WpaT + 256, scr, r, lane, 512); continue; } r -= I_PA;
                    if (r < I_OUT) { transpose_item<0>(w_out, D, D, WoutT, scr, r, lane); continue; } r -= I_OUT;
                    if (r < I_GU) { transpose_item<2>(w_gu, D, NGU, WguT, scr, r, lane); continue; } r -= I_GU;
                    transpose_item<0>(w_down, FFH, D, WdT, scr, r, lane);
                }
            }
        }
    } }
    SEAM(1);

    for (int rep_ = 0; rep_ < NREP(2); ++rep_) { if (rep_) xcd_barrier(xbar);
    if (IN(2)) {
        LANE_TID(); (void)tid;
        constexpr int RS = 192, NU = NHEAD * 128;
        const bf16_t* QKV = WSP(bf16_t, WS_QKV); const bf16_t* Ub = WSP(bf16_t, WS_U); bf16_t* OG = WSP(bf16_t, WS_OG); float* LSE = WSP(float, WS_LSE); bf16_t* YP = WSP(bf16_t, WS_OA);
        const bf16_t* WmT = WSP(bf16_t, WS_WMT); const float* pool_scale = args.in[4];
        LAS unsigned char* Kl = lds; LAS unsigned char* Vl = lds + 272 * RS;
        const int c = lane & 15, q = lane >> 4;
        const int rq = tid >> 3, ch = tid & 7, chs = ch ^ ((rq >> 2) & 3);
        for (int i = tid; i < 2 * 768; i += 512) { LAS unsigned char* base = (i < 768) ? Kl : Vl; const int j = (i < 768) ? i : i - 768; *(LAS unsigned*)(base + 256 * RS + 4 * j) = 0u; }
#define AU_OF(un_, h_, row0_, sh_, first_) const int h_ = (un_) >> 7, row0_ = ((un_) & 127) * 128, sh_ = 2 * (h_ >> 2); const bool first_ = (row0_ & ((S >> sh_) - 1)) == 0
#define KV_LOAD(kv, h_, row0_, first_) do { const bf16_t* pk_ = QKV + ((size_t)(NHEAD + (h_)) * S + ((row0_) - 128 + rq)) * HD + 8 * ch; const bf16_t* pv_ = QKV + ((size_t)(2 * NHEAD + (h_)) * S + ((row0_) - 128 + rq)) * HD + 8 * ch; \
            _Pragma("unroll") for (int i_ = 0; i_ < 4; ++i_) { if (i_ >= 2 || !(first_)) { kv[i_] = *(const u32x4*)(pk_ + (size_t)i_ * 64 * HD); kv[4 + i_] = *(const u32x4*)(pv_ + (size_t)i_ * 64 * HD); } \
                else { kv[i_] = (u32x4){0u, 0u, 0u, 0u}; kv[4 + i_] = (u32x4){0u, 0u, 0u, 0u}; } } } while (0)
#define KV_WRITE(kv) do { _Pragma("unroll") for (int i_ = 0; i_ < 4; ++i_) { *(LAS u32x4*)(Kl + (64 * i_ + rq) * RS + chs * 16) = kv[i_]; *(LAS u32x4*)(Vl + (64 * i_ + rq) * RS + chs * 16) = kv[4 + i_]; } } while (0)
#define Q_LOAD(qf, h_, row0_) do { const bf16_t* Qp_ = QKV + ((size_t)(h_) * S + ((row0_) + 16 * wave + c)) * HD + 8 * q; qf[0] = *(const bf16x8*)Qp_; qf[1] = *(const bf16x8*)(Qp_ + 32); } while (0)
        typedef short s16x4 __attribute__((ext_vector_type(4)));
        u32x4 kv[8], kw[8]; bf16x8 qf[2], qn[2];
        int un = blockIdx.x;
        if (un < NU) { AU_OF(un, h0, r0, s0, f0); (void)s0; KV_LOAD(kv, h0, r0, f0); Q_LOAD(qf, h0, r0); }
        if (un + G < NU) { AU_OF(un + G, h1, r1, s1, f1); (void)s1; KV_LOAD(kw, h1, r1, f1); }
        for (; un < NU; un += G) {
            AU_OF(un, h, row0, sh, first);
            const int un2 = un + G; const bool has2 = un2 < NU;
            AU_OF((has2 ? un2 : un), h2, row2, sh2, first2); (void)sh2; (void)first2;
            const int un3 = un + 2 * G; const bool has3 = un3 < NU;
            AU_OF((has3 ? un3 : un), h3, row3, sh3, first3); (void)sh3;
            __syncthreads();
            KV_WRITE(kv);
            __syncthreads();
            if (has2) {
#pragma unroll
                for (int i_ = 0; i_ < 8; ++i_) kv[i_] = kw[i_];
                Q_LOAD(qn, h2, row2);
            }
            if (has3) KV_LOAD(kw, h3, row3, first3);
            const int L = S >> sh;
            {
                const int qrow = row0 + 16 * wave + c;
                f32x4 sc[10];
#pragma unroll
                for (int t = 0; t < 10; ++t) {
                    const int krow = 16 * wave + 32 * (t >> 1) + 8 * (c >> 2) + 4 * (t & 1) + (c & 3);
                    const int kx = (q ^ ((2 * (c >> 2) + (t & 1)) & 3)) * 16;
                    const bf16x8 k0 = *(const LAS bf16x8*)(Kl + krow * RS + kx), k1 = *(const LAS bf16x8*)(Kl + krow * RS + 64 + kx);
                    f32x4 a = (f32x4){0.f, 0.f, 0.f, 0.f};
                    a = __builtin_amdgcn_mfma_f32_16x16x32_bf16(k0, qf[0], a, 0, 0, 0);
                    a = __builtin_amdgcn_mfma_f32_16x16x32_bf16(k1, qf[1], a, 0, 0, 0);
                    sc[t] = a;
                }
                const int ql = 128 + 16 * wave + c;
                float mx = -1e30f;
#pragma unroll
                for (int t = 0; t < 10; ++t)
#pragma unroll
                    for (int rg = 0; rg < 4; ++rg) {
                        const int kl = 16 * wave + 32 * (t >> 1) + 8 * q + 4 * (t & 1) + rg, dist = ql - kl;
                        const bool valid = dist >= 0 && dist <= 128 && (kl >= 128 || !first);
                        const float sv = valid ? sc[t][rg] * 0.18033688011112042f : -1e30f;
                        sc[t][rg] = sv; mx = fmaxf(mx, sv);
                    }
                mx = fmaxf(mx, __shfl_xor(mx, 16)); mx = fmaxf(mx, __shfl_xor(mx, 32));
                float lsum = 0.f;
#pragma unroll
                for (int t = 0; t < 10; ++t)
#pragma unroll
                    for (int rg = 0; rg < 4; ++rg) { const float pv = __builtin_amdgcn_exp2f(sc[t][rg] - mx); sc[t][rg] = pv; lsum += pv; }
                lsum += __shfl_xor(lsum, 16); lsum += __shfl_xor(lsum, 32);
                f32x4 o[4];
#pragma unroll
                for (int dt = 0; dt < 4; ++dt) o[dt] = (f32x4){0.f, 0.f, 0.f, 0.f};
#pragma unroll
                for (int cc = 0; cc < 5; ++cc) {
                    u32x4 pw; pw.x = pk2(sc[2 * cc][0], sc[2 * cc][1]); pw.y = pk2(sc[2 * cc][2], sc[2 * cc][3]); pw.z = pk2(sc[2 * cc + 1][0], sc[2 * cc + 1][1]); pw.w = pk2(sc[2 * cc + 1][2], sc[2 * cc + 1][3]);
                    const bf16x8 pf = __builtin_bit_cast(bf16x8, pw);
                    LAS unsigned char* vb = Vl + (16 * wave + 32 * cc + 8 * q + (c >> 2)) * RS + 8 * (c & 1);
                    const int px = (c >> 1) & 1, x0 = (2 * q) & 3, x1 = (2 * q + 1) & 3;
#pragma unroll
                    for (int dt = 0; dt < 4; ++dt) {
                        const s16x4 v0 = __builtin_bit_cast(s16x4, __builtin_amdgcn_ds_read_tr16_b64_v4i16((LAS s16x4*)(vb + 16 * ((2 * dt + px) ^ x0))));
                        const s16x4 v1 = __builtin_bit_cast(s16x4, __builtin_amdgcn_ds_read_tr16_b64_v4i16((LAS s16x4*)(vb + 4 * RS + 16 * ((2 * dt + px) ^ x1))));
                        bf16x8 vf; vf[0] = v0[0]; vf[1] = v0[1]; vf[2] = v0[2]; vf[3] = v0[3]; vf[4] = v1[0]; vf[5] = v1[1]; vf[6] = v1[2]; vf[7] = v1[3];
                        o[dt] = __builtin_amdgcn_mfma_f32_16x16x32_bf16(vf, pf, o[dt], 0, 0, 0);
                    }
                }
                const float inv = 1.0f / lsum;
                const int tok = ((qrow & (L - 1)) << sh) + (qrow >> (14 - sh));
                bf16_t* op = OG + ((size_t)h * S + tok) * HD + 4 * q;
#pragma unroll
                for (int dt = 0; dt < 4; ++dt) { u32x2 w; w.x = pk2(o[dt][0] * inv, o[dt][1] * inv); w.y = pk2(o[dt][2] * inv, o[dt][3] * inv); *(u32x2*)(op + 16 * dt) = w; }
                if (q == 0) LSE[(size_t)h * S + tok] = (mx + __log2f(lsum)) * 0.6931471805599453f;
            }
            qf[0] = qn[0]; qf[1] = qn[1];
        }
#undef AU_OF
#undef KV_LOAD
#undef KV_WRITE
#undef Q_LOAD
        for (int wu = gw; wu < (S / 16) * 4; wu += NGW) {
            const int tt = wu >> 2, g = wu & 3;
            if (g == 0) pool_unit<2>(Ub, WmT, pool_scale, YP, tt, 0, c, q);
            else if (g == 1) pool_unit<4>(Ub, WmT, pool_scale, YP, tt, 1, c, q);
            else if (g == 2) pool_unit<8>(Ub, WmT, pool_scale, YP, tt, 2, c, q);
            else pool_unit<16>(Ub, WmT, pool_scale, YP, tt, 3, c, q);
        }
    } }
    SEAM(2);

    for (int rep_ = 0; rep_ < NREP(3); ++rep_) { if (rep_) xcd_barrier(xbar);
    if (IN(3)) {
        LANE_TID(); (void)tid;
        const bf16_t* OG = WSP(bf16_t, WS_OG); const float* LSE = WSP(float, WS_LSE); bf16_t* OA = WSP(bf16_t, WS_OA);
        for (int e0 = blockIdx.x * 512 + tid; e0 < S * 32; e0 += 4 * G * 512) {
            float l0[4], l1[4], l2[4]; u32x4 v0[4], v1[4], v2[4];
#pragma unroll
            for (int k = 0; k < 4; ++k) {
                const int e = e0 + k * G * 512, ec = e < S * 32 ? e : e0;
                const int d8 = ec & 7, j = (ec >> 3) & 3, t = ec >> 5;
                l0[k] = LSE[(size_t)(0 + j) * S + t]; l1[k] = LSE[(size_t)(4 + j) * S + t]; l2[k] = LSE[(size_t)(8 + j) * S + t];
                v0[k] = *(const u32x4*)(OG + ((size_t)(0 + j) * S + t) * HD + 8 * d8); v1[k] = *(const u32x4*)(OG + ((size_t)(4 + j) * S + t) * HD + 8 * d8); v2[k] = *(const u32x4*)(OG + ((size_t)(8 + j) * S + t) * HD + 8 * d8);
            }
#pragma unroll
            for (int k = 0; k < 4; ++k) {
                const int e = e0 + k * G * 512;
                if (e < S * 32) {
                    const int d8 = e & 7, j = (e >> 3) & 3, t = e >> 5;
                    const float mx = fmaxf(l0[k], fmaxf(l1[k], l2[k]));
                    float w0 = __expf(l0[k] - mx), w1 = __expf(l1[k] - mx), w2 = __expf(l2[k] - mx);
                    const float inv = __builtin_amdgcn_rcpf(w0 + w1 + w2); w0 *= inv; w1 *= inv; w2 *= inv;
                    u32x4 o;
#pragma unroll
                    for (int i = 0; i < 4; ++i) {
                        const float a = w0 * bf2f(v0[k][i] & 0xffffu) + w1 * bf2f(v1[k][i] & 0xffffu) + w2 * bf2f(v2[k][i] & 0xffffu);
                        const float bb = w0 * bf2f(v0[k][i] >> 16) + w1 * bf2f(v1[k][i] >> 16) + w2 * bf2f(v2[k][i] >> 16);
                        o[i] = pk2(a, bb);
                    }
                    *(u32x4*)(OA + (size_t)t * 512 + 64 * j + 8 * d8) = o;
                }
            }
        }
    } }
    SEAM(3);

    for (int rep_ = 0; rep_ < NREP(4); ++rep_) { if (rep_) xcd_barrier(xbar);
    if (IN(4)) {
        LANE_TID(); (void)tid;
        int K1 = 512; asm volatile("" : "+s"(K1));
        pg8::Gemm g{WSP(bf16_t, WS_OA), WSP(bf16_t, WS_WPA), S, D, K1}; pg8::StaticOrder So; So.init(S, D, G, (int)blockIdx.x);
        EpiGate2 E{WSP(bf16_t, WS_GATES), WSP(bf16_t, WS_H)};
        pg8::gemm_phase<EpiGate2, pg8::StaticOrder, true, true>(lds, g, So, E, wave, lane);
    } }
    SEAM(4);

    { const int rep_ = 0; (void)rep_;
    if (IN(5)) {
        LANE_TID(); (void)tid;
        pg8::Gemm g{WSP(bf16_t, WS_H), WSP(bf16_t, WS_WOUT), S, D, D}; pg8::StaticOrder So; So.init(S, D, G, (int)blockIdx.x);
        RowStats st1{WSP(unsigned, WS_XBUF + (size_t)rep_ * 786432), WSP(unsigned, WS_CTL) + (rep_ ? 20480 : 1024)}; RowStats st2{WSP(unsigned, WS_XBUF + 262144 + (size_t)rep_ * 786432), WSP(unsigned, WS_CTL) + (rep_ ? 20480 : 1024) + 4096};
        EpiRmsResRms E{args.in[0], WSP(bf16_t, WS_X1), WSP(bf16_t, WS_H2), args.in[8], args.in[9], st1, st2};
        pg8::gemm_phase<EpiRmsResRms, pg8::StaticOrder, false, true>(lds, g, So, E, wave, lane);
    } }
    SEAM(5);

    for (int rep_ = 0; rep_ < NREP(7); ++rep_) { if (rep_) xcd_barrier(xbar);
    if (IN(7)) {
        LANE_TID(); (void)tid;
        pg8::Gemm g{WSP(bf16_t, WS_H2), WSP(bf16_t, WS_WGU), S, NGU, D}; pg8::StaticOrder So; So.init(S, NGU, G, (int)blockIdx.x);
        EpiSwiglu E{WSP(bf16_t, WS_ACT)};
        pg8::gemm_phase<EpiSwiglu, pg8::StaticOrder, true, true>(lds, g, So, E, wave, lane);
    } }
    SEAM(7);

    { const int rep_ = 0; (void)rep_;
    if (IN(8)) {
        LANE_TID(); (void)tid;
        pg8::Gemm g{WSP(bf16_t, WS_ACT), WSP(bf16_t, WS_WD), S, D, FFH}; pg8::StaticOrder So; So.init(S, D, G, (int)blockIdx.x);
        RowStats st{WSP(unsigned, WS_XBUF + 2 * 262144 + (size_t)rep_ * 786432), WSP(unsigned, WS_CTL) + (rep_ ? 20480 : 1024) + 2 * 4096};
        EpiRmsRes E{WSP(bf16_t, WS_X1), args.out, args.in[12], st};
        pg8::gemm_phase<EpiRmsRes, pg8::StaticOrder, false, true>(lds, g, So, E, wave, lane);
    } }
#undef IN
#undef LANE_TID
#undef WSP
#undef SEAM
}

extern "C" void kernel_launch(void* const* d_in, const int* in_sizes, int n_in, void* d_out, int out_size, void* d_ws, size_t ws_size, hipStream_t stream) {
    static int grid = 0;
    if (grid == 0) {
        if (n_in != 13 || in_sizes[0] != S * D || out_size != S * D || ws_size < WS_END) { fprintf(stderr, "kernel_launch: unexpected shapes (n_in %d, in0 %d, out %d, ws %zu)\n", n_in, n_in > 0 ? in_sizes[0] : -1, out_size, ws_size); grid = -1; return; }
        int dev = 0, cus = 0, per_cu = 0;
        (void)hipGetDevice(&dev);
        (void)hipDeviceGetAttribute(&cus, hipDeviceAttributeMultiprocessorCount, dev);
        if (hipFuncSetAttribute((const void*)fwd_mega, hipFuncAttributeMaxDynamicSharedMemorySize, LDS_BYTES) != hipSuccess) fprintf(stderr, "kernel_launch: hipFuncSetAttribute failed\n");
        if (hipOccupancyMaxActiveBlocksPerMultiprocessor(&per_cu, (const void*)fwd_mega, 512, LDS_BYTES) != hipSuccess || per_cu < 1) { fprintf(stderr, "kernel_launch: occupancy query says %d\n", per_cu); per_cu = 1; }
        (void)hipGetLastError();
        if (cus <= 0) cus = 256;
        grid = cus * per_cu;
    }
    if (grid < 0) return;
    Args a{};
    for (int i = 0; i < 13; ++i) a.in[i] = (const float*)d_in[i];
    a.out = (float*)d_out; a.ws = (unsigned char*)d_ws;
    for (int f = 0; f < 32; ++f) a.invf[f] = (float)pow(10000.0, -(double)f / 32.0);
    a.lo = 0; a.hi = NPHASE;
    (void)hipMemsetAsync((unsigned char*)d_ws + WS_CTL, 0, CTL_ZERO_BYTES, stream);
    void* kargs[] = {&a};
    hipError_t e = hipLaunchCooperativeKernel((const void*)fwd_mega, dim3(grid), dim3(512), kargs, LDS_BYTES, stream);
    if (e != hipSuccess) fprintf(stderr, "kernel_launch: cooperative launch failed: %s (grid %d)\n", hipGetErrorString(e), grid);
}
```

```cpp
#include <hip/hip_runtime.h>
#include <hip/hip_cooperative_groups.h>
#include <cstdio>
#include <cstdint>
#include <cmath>
namespace cg = cooperative_groups;
namespace pg8 {
#define PG8_LAS __attribute__((address_space(3)))
typedef unsigned short bf16_t;
typedef short bf16x8 __attribute__((ext_vector_type(8)));
typedef float f32x4 __attribute__((ext_vector_type(4)));
typedef unsigned u32x4 __attribute__((ext_vector_type(4)));
constexpr int BM = 256, BK = 64, HALF = 128, HTB = HALF * BK * 2  , STAGE_BYTES = 8 * HTB, NXCD = 8, WGM = 8;

__host__ __device__ __forceinline__ int lds_byte(int r, int c) { const int st = (r >> 4) * 2 + (c >> 5), rr = r & 15, cc = c & 31, ob = rr * 64 + cc * 2; return st * 1024 + (ob ^ (((ob >> 9) & 1) << 5)); }
__host__ __device__ __forceinline__ void stage_rc(int b, int& R, int& C) { const int st = b / 1024, sb = b % 1024, swz = sb ^ (((sb >> 9) & 1) << 5); R = (st >> 1) * 16 + swz / 64; C = (st & 1) * 32 + (swz % 64) / 2; }
__host__ __device__ __forceinline__ int perm32(int rho) { const int n = rho >> 4, i = rho & 15; return 8 * (i >> 2) + 4 * n + (i & 3); }

struct Unit { int pm, pn; };
struct Gemm { const bf16_t* A; const bf16_t* Bt; int M, N, K; };

struct StaticOrder {
    int nM, nN, nwg, G, c;
    __host__ __device__ void init(int M, int N, int G_, int c_) { nM = M / BM; nN = N / BM; nwg = nM * nN; G = G_; c = c_; }
    __host__ __device__ bool next(int i, Unit& u) const {
        const long L = (long)i * G + c; if (L >= nwg) return false;
        int wgid = (int)L; { const int q = nwg / NXCD, r = nwg % NXCD, xcd = wgid % NXCD, off = wgid / NXCD; wgid = (xcd < r ? xcd * (q + 1) : r * (q + 1) + (xcd - r) * q) + off; }
        const int nig = WGM * nN, gid = wgid / nig, fm = gid * WGM, gsz = (nM - fm) < WGM ? (nM - fm) : WGM;
        u.pm = fm + ((wgid % nig) % gsz); u.pn = (wgid % nig) / gsz; return true;
    }
    __device__ __forceinline__ void a_ready(const Unit&) const {}
    __device__ __forceinline__ void done(const Unit&) const {}
};
__device__ __forceinline__ unsigned cvt_pk_bf16(float lo, float hi) { unsigned r; asm volatile("v_cvt_pk_bf16_f32 %0, %1, %2" : "=v"(r) : "v"(lo), "v"(hi)); return r; }
typedef float f32x2 __attribute__((ext_vector_type(2)));
template <class Epi, class Sched, bool ALIGN_EPI = false, bool SP2 = false>
__device__ __forceinline__ void gemm_phase(PG8_LAS unsigned char* lds, const Gemm g, const Sched& S, const Epi& E, const int wid, const int lane) {
    const int tid = wid * 64 + lane, wr = wid >> 2, wc = wid & 3, fr = lane & 15, fq = lane >> 4;
    const int K = g.K, nt = K / BK;
    unsigned voffA[2], voffB[2];
#pragma unroll
    for (int i = 0; i < 2; ++i) { int R, C; stage_rc(tid * 16 + i * 8192, R, C); const int Rb = Epi::PERM ? ((R & ~31) + perm32(R & 31)) : R;
        voffA[i] = (unsigned)(R * K + C) * 2u; voffB[i] = (unsigned)(Rb * K + C) * 2u; }
    const size_t kstep = (size_t)(BK * 2);
    const size_t hstep = (size_t)HALF * K * 2;
    const size_t tstep = 2 * hstep;
    const unsigned ldsw = (unsigned)wid * 1024u;
    const int aoff = lds_byte(wr * 64 + fr, fq * 8), boff = lds_byte(wc * 32 + fr, fq * 8);
#define PG8_SA(b, h) (((b) * 2 + (h)) * HTB)
#define PG8_SB(b, h) ((4 + (b) * 2 + (h)) * HTB)
#define PG8_STAGE(bufoff, gbase, voff) do { _Pragma("unroll") for (int _i = 0; _i < 2; ++_i) \
        __builtin_amdgcn_global_load_lds((const unsigned*)((const char*)(gbase) + (voff)[_i]), (PG8_LAS unsigned*)(lds + (bufoff) + ldsw + _i * 8192), 16, 0, 0); } while (0)
#define PG8_LDA(dst, b, h) do { _Pragma("unroll") for (int m = 0; m < 4; ++m) _Pragma("unroll") for (int k = 0; k < 2; ++k) dst[m][k] = *(const PG8_LAS bf16x8*)(lds + PG8_SA(b, h) + aoff + m * 2048 + k * 1024); } while (0)
#define PG8_LDB(dst, b, h) do { _Pragma("unroll") for (int n = 0; n < 2; ++n) _Pragma("unroll") for (int k = 0; k < 2; ++k) dst[n][k] = *(const PG8_LAS bf16x8*)(lds + PG8_SB(b, h) + boff + n * 2048 + k * 1024); } while (0)
#define PG8_MMA(ai, bj, At, Bt) do { __builtin_amdgcn_s_setprio(1); _Pragma("unroll") for (int m = 0; m < 4; ++m) _Pragma("unroll") for (int n = 0; n < 2; ++n) _Pragma("unroll") for (int k = 0; k < 2; ++k) \
        acc[ai][bj][m][n] = __builtin_amdgcn_mfma_f32_16x16x32_bf16(Bt[n][k], At[m][k], acc[ai][bj][m][n], 0, 0, 0); __builtin_amdgcn_s_setprio(0); } while (0)
#define PG8_WAIT_V(n) asm volatile("s_waitcnt vmcnt(" #n ")" ::: "memory")
#define PG8_WAIT_L(n) asm volatile("s_waitcnt lgkmcnt(" #n ")" ::: "memory")
#define PG8_BAR __builtin_amdgcn_s_barrier()
#define PG8_SCHED __builtin_amdgcn_sched_barrier(0)
    Unit cur, nxt; int ui = 0;
    if (!S.next(0, cur)) return;
    f32x4 acc[2][2][4][2];
#pragma unroll
    for (int a = 0; a < 2; ++a)
#pragma unroll
        for (int b = 0; b < 2; ++b)
#pragma unroll
            for (int m = 0; m < 4; ++m)
#pragma unroll
                for (int n = 0; n < 2; ++n) acc[a][b][m][n] = (f32x4){0.f, 0.f, 0.f, 0.f};
    bf16x8 At[4][2], B0[2][2], B1[2][2];
    const char* cA = (const char*)g.A + (size_t)cur.pm * tstep; const char* cB = (const char*)g.Bt + (size_t)cur.pn * tstep;
    S.a_ready(cur);
    if constexpr (SP2) {
        PG8_STAGE(PG8_SB(0, 0), cB, voffB); PG8_STAGE(PG8_SB(0, 1), cB + hstep, voffB); PG8_STAGE(PG8_SA(0, 0), cA, voffA); PG8_STAGE(PG8_SA(0, 1), cA + hstep, voffA);
        if (wr == 1) PG8_BAR;
        PG8_WAIT_V(2); PG8_BAR;
        PG8_STAGE(PG8_SB(1, 0), cB + kstep, voffB); PG8_STAGE(PG8_SA(1, 0), cA + kstep, voffA); PG8_STAGE(PG8_SB(1, 1), cB + hstep + kstep, voffB);
        PG8_WAIT_V(6); PG8_BAR;
    } else {
        PG8_STAGE(PG8_SB(0, 0), cB, voffB); PG8_STAGE(PG8_SA(0, 0), cA, voffA); PG8_STAGE(PG8_SB(0, 1), cB + hstep, voffB); PG8_STAGE(PG8_SA(0, 1), cA + hstep, voffA);
        if (wr == 1) PG8_BAR;
        PG8_WAIT_V(4); PG8_BAR;
        PG8_STAGE(PG8_SB(1, 0), cB + kstep, voffB); PG8_STAGE(PG8_SA(1, 0), cA + kstep, voffA); PG8_STAGE(PG8_SB(1, 1), cB + hstep + kstep, voffB);
        PG8_WAIT_V(6); PG8_BAR;
    }
    for (;;) {
        const bool has_next = S.next(ui + 1, nxt);
        const char* nA = has_next ? (const char*)g.A + (size_t)nxt.pm * tstep : cA; const char* nB = has_next ? (const char*)g.Bt + (size_t)nxt.pn * tstep : cB;
        for (int t = 0; t < nt; t += 2) {
            if constexpr (Epi::HAS_MID) { if (t == (nt >> 1)) E.mid(acc, cur, wr, wc, fr, fq); }
            const bool last = (t == nt - 2);
            const char* a1 = cA + (size_t)(t + 1) * kstep;
            const char* a2 = last ? nA : cA + (size_t)(t + 2) * kstep; const char* b2 = last ? nB : cB + (size_t)(t + 2) * kstep;
            const char* a3 = a2 + kstep; const char* b3 = b2 + kstep;
            if (last && has_next) S.a_ready(nxt);
            if constexpr (SP2) {
            PG8_LDB(B0, 0, 0); PG8_LDB(B1, 0, 1); PG8_SCHED; PG8_LDA(At, 0, 0); PG8_STAGE(PG8_SA(1, 1), a1 + hstep, voffA);
            PG8_WAIT_V(8); PG8_WAIT_L(0); PG8_BAR; PG8_MMA(0, 0, At, B0); PG8_MMA(0, 1, At, B1); PG8_BAR; PG8_SCHED;
            PG8_LDA(At, 0, 1); PG8_STAGE(PG8_SB(0, 0), b2, voffB); PG8_STAGE(PG8_SB(0, 1), b2 + hstep, voffB); PG8_STAGE(PG8_SA(0, 0), a2, voffA);
            PG8_WAIT_V(8); PG8_WAIT_L(0); PG8_BAR; PG8_MMA(1, 0, At, B0); PG8_MMA(1, 1, At, B1); PG8_BAR; PG8_SCHED;
            PG8_LDB(B0, 1, 0); PG8_LDB(B1, 1, 1); PG8_SCHED; PG8_LDA(At, 1, 0); PG8_STAGE(PG8_SA(0, 1), a2 + hstep, voffA);
            PG8_WAIT_V(8); PG8_WAIT_L(0); PG8_BAR; PG8_MMA(0, 0, At, B0); PG8_MMA(0, 1, At, B1); PG8_BAR; PG8_SCHED;
            PG8_LDA(At, 1, 1); PG8_STAGE(PG8_SB(1, 0), b3, voffB); PG8_STAGE(PG8_SB(1, 1), b3 + hstep, voffB); PG8_STAGE(PG8_SA(1, 0), a3, voffA);
            PG8_WAIT_V(8); PG8_WAIT_L(0); PG8_BAR; PG8_MMA(1, 0, At, B0); PG8_MMA(1, 1, At, B1); PG8_BAR; PG8_SCHED;
            } else {
            PG8_LDB(B0, 0, 0); PG8_SCHED; PG8_LDA(At, 0, 0); PG8_STAGE(PG8_SA(1, 1), a1 + hstep, voffA);
            PG8_WAIT_L(8); PG8_BAR; PG8_WAIT_L(0); PG8_MMA(0, 0, At, B0); PG8_BAR; PG8_SCHED;
            PG8_LDB(B1, 0, 1); PG8_STAGE(PG8_SB(0, 0), b2, voffB);
            PG8_BAR; PG8_WAIT_L(0); PG8_MMA(0, 1, At, B1); PG8_BAR;
            PG8_LDA(At, 0, 1); PG8_STAGE(PG8_SA(0, 0), a2, voffA);
            PG8_BAR; PG8_WAIT_L(0); PG8_MMA(1, 0, At, B0); PG8_BAR; PG8_SCHED;
            PG8_STAGE(PG8_SB(0, 1), b2 + hstep, voffB);
            PG8_WAIT_V(6); PG8_BAR; PG8_MMA(1, 1, At, B1); PG8_BAR;
            PG8_LDB(B0, 1, 0); PG8_SCHED; PG8_LDA(At, 1, 0); PG8_STAGE(PG8_SA(0, 1), a2 + hstep, voffA);
            PG8_WAIT_L(8); PG8_BAR; PG8_WAIT_L(0); PG8_MMA(0, 0, At, B0); PG8_BAR; PG8_SCHED;
            PG8_LDB(B1, 1, 1); PG8_STAGE(PG8_SB(1, 0), b3, voffB);
            PG8_BAR; PG8_WAIT_L(0); PG8_MMA(0, 1, At, B1); PG8_BAR;
            PG8_LDA(At, 1, 1); PG8_STAGE(PG8_SA(1, 0), a3, voffA);
            PG8_BAR; PG8_WAIT_L(0); PG8_MMA(1, 0, At, B0); PG8_BAR; PG8_SCHED;
            PG8_STAGE(PG8_SB(1, 1), b3 + hstep, voffB);
            PG8_WAIT_V(6); PG8_BAR; PG8_MMA(1, 1, At, B1); PG8_BAR;
            }
        }
        if constexpr (ALIGN_EPI) { if (wr == 0) PG8_BAR; }
        if constexpr (!Epi::AFTER_DRAIN) { E(acc, cur, wr, wc, fr, fq); S.done(cur); }
        if (!has_next) break;
#pragma unroll
        for (int a = 0; a < 2; ++a)
#pragma unroll
            for (int b = 0; b < 2; ++b)
#pragma unroll
                for (int m = 0; m < 4; ++m)
#pragma unroll
                    for (int n = 0; n < 2; ++n) acc[a][b][m][n] = (f32x4){0.f, 0.f, 0.f, 0.f};
        cur = nxt; cA = nA; cB = nB; ++ui;
        if constexpr (ALIGN_EPI) { if (wr == 1) PG8_BAR; }
    }
    PG8_WAIT_V(0);
    if constexpr (!ALIGN_EPI) { if (wr == 0) PG8_BAR; }
    PG8_BAR;
    if constexpr (Epi::AFTER_DRAIN) { E.fused(acc, cur, wr, wc, fr, fq, lds, wid, lane); S.done(cur); }
#undef PG8_SA
#undef PG8_SB
#undef PG8_STAGE
#undef PG8_LDA
#undef PG8_LDB
#undef PG8_MMA
#undef PG8_WAIT_V
#undef PG8_WAIT_L
#undef PG8_BAR
#undef PG8_SCHED
}
}
#ifndef REP_PHASE
#define REP_PHASE -1
#endif
#define NREP(k) ((k) == REP_PHASE ? 2 : 1)

constexpr int S = 16384, D = 1024, NIN = 4608, FFH = 2816, NGU = 2 * FFH;
constexpr int NHEAD = 12, HD = 64;
constexpr float EPS = 1e-6f;
constexpr int LDS_BYTES = 147456;
constexpr int NPHASE = 10;

#define LAS __attribute__((address_space(3)))
typedef unsigned short bf16_t;
typedef short bf16x8 __attribute__((ext_vector_type(8)));
typedef float f32x4 __attribute__((ext_vector_type(4)));
typedef unsigned u32x4 __attribute__((ext_vector_type(4)));
typedef unsigned u32x2 __attribute__((ext_vector_type(2)));

constexpr size_t MiB = 1u << 20;
constexpr size_t WS_WIN = 0;
constexpr size_t WS_WPA = 9 * MiB;
constexpr size_t WS_WOUT = 10 * MiB;
constexpr size_t WS_WGU = 12 * MiB;
constexpr size_t WS_WD = 23 * MiB;
constexpr size_t WS_WMT = 29 * MiB;
constexpr size_t WS_TAB = 30 * MiB;
constexpr size_t WS_H = 34 * MiB;
constexpr size_t WS_QKV = 66 * MiB;
constexpr size_t WS_U = 138 * MiB;
constexpr size_t WS_GATES = 146 * MiB;
constexpr size_t WS_OG = 210 * MiB;
constexpr size_t WS_LSE = 234 * MiB;
constexpr size_t WS_OA = 235 * MiB;
constexpr size_t WS_H2 = 154 * MiB;
constexpr size_t WS_X1 = 186 * MiB;
constexpr size_t WS_ACT = 66 * MiB;
constexpr size_t WS_CTL = 251 * MiB;
constexpr size_t CTL_ZERO_BYTES = 131072;
constexpr int CW_XBAR = 16384;
constexpr size_t WS_XBUF = 251 * MiB + 131072;
constexpr size_t WS_END = (REP_PHASE >= 0 ? 253 : 252) * MiB;

__device__ __forceinline__ float bf2f(unsigned bits16) { return __builtin_bit_cast(float, bits16 << 16); }
typedef float f32x2_t __attribute__((ext_vector_type(2)));
typedef __bf16 bf16x2_t __attribute__((ext_vector_type(2)));
__device__ __forceinline__ unsigned pk2(float lo, float hi) { f32x2_t v = {lo, hi}; bf16x2_t b = __builtin_convertvector(v, bf16x2_t); return __builtin_bit_cast(unsigned, b); }
__device__ __forceinline__ float wave_sum(float v) {
#pragma unroll
    for (int o = 1; o < 64; o <<= 1) v += __shfl_xor(v, o);
    return v;
}
__device__ __forceinline__ int lane_id_asm() { int l; asm volatile("v_mbcnt_lo_u32_b32 %0, -1, 0\n\tv_mbcnt_hi_u32_b32 %0, -1, %0" : "=v"(l)); return l; }
__device__ __forceinline__ float sigmoidf_(float v) { return __builtin_amdgcn_rcpf(1.0f + __builtin_amdgcn_exp2f(v * -1.4426950408889634f)); }

__host__ __device__ __forceinline__ int in_tile(int pn) { return pn < 8 ? pn + 10 : (pn < 14 ? pn - 8 : (pn == 14 ? 9 : pn - 9)); }
#define OPQ(p) asm volatile("" : "+v"(p))
#define EPI_ROWS_BEGIN _Pragma("unroll") for (int ai = 0; ai < 2; ++ai) { _Pragma("unroll") for (int m = 0; m < 4; ++m) {
#define EPI_ROWS_END(step16, step64) } }
struct EpiIn {
    static constexpr bool PERM = true, AFTER_DRAIN = false, HAS_MID = false;
    bf16_t* qkv; bf16_t* ub; bf16_t* gates; const float* tab;
    __device__ __forceinline__ void operator()(const f32x4 (&acc)[2][2][4][2], const pg8::Unit& u, int wr, int wc, int fr, int fq) const {
        const int pn = in_tile(u.pn);
        const int r0 = u.pm * 256 + wr * 64 + fr;
        if (pn < 6) {
            const int T = pn / 3, g3 = pn - 3 * T, sh = 2 * g3;
            const int rowp0 = ((r0 & ((1 << sh) - 1)) << (14 - sh)) + (r0 >> sh);
            bf16_t* dst = qkv + (((size_t)T * NHEAD + g3 * 4 + wc) * S + rowp0) * HD + 8 * fq;
            const float* tp = tab + ((size_t)r0 * 32 + 8 * fq) * 2;
            const int dstep = (16 >> sh) * HD;
#pragma unroll
            for (int ai = 0; ai < 2; ++ai) {
#pragma unroll
                for (int m = 0; m < 4; ++m) {
                    u32x4 w1, w2;
#pragma unroll
                    for (int n = 0; n < 2; ++n) {
                        const f32x4 cs0 = *(const f32x4*)(tp + 8 * n), cs1 = *(const f32x4*)(tp + 8 * n + 4);
                        const f32x4 a = acc[ai][0][m][n], b = acc[ai][1][m][n];
                        const float o10 = a[0] * cs0[0] - b[0] * cs0[1], o20 = b[0] * cs0[0] + a[0] * cs0[1];
                        const float o11 = a[1] * cs0[2] - b[1] * cs0[3], o21 = b[1] * cs0[2] + a[1] * cs0[3];
                        const float o12 = a[2] * cs1[0] - b[2] * cs1[1], o22 = b[2] * cs1[0] + a[2] * cs1[1];
                        const float o13 = a[3] * cs1[2] - b[3] * cs1[3], o23 = b[3] * cs1[2] + a[3] * cs1[3];
                        w1[2 * n] = pk2(o10, o11); w1[2 * n + 1] = pk2(o12, o13); w2[2 * n] = pk2(o20, o21); w2[2 * n + 1] = pk2(o22, o23);
                    }
                    *(u32x4*)dst = w1; *(u32x4*)(dst + 32) = w2;
                    dst += dstep; tp += 16 * 64; OPQ(dst); OPQ(tp);
                }
                dst += 4 * dstep; tp += 64 * 64; OPQ(dst); OPQ(tp);
            }
        } else if (pn < 9) {
            const int g3 = pn - 6, sh = 2 * g3;
            const int rowp0 = ((r0 & ((1 << sh) - 1)) << (14 - sh)) + (r0 >> sh);
            bf16_t* dst = qkv + (((size_t)2 * NHEAD + g3 * 4 + (wc >> 1)) * S + rowp0) * HD + 32 * (wc & 1) + 8 * fq;
            const int dstep = (16 >> sh) * HD;
#pragma unroll
            for (int ai = 0; ai < 2; ++ai) {
#pragma unroll
                for (int m = 0; m < 4; ++m) {
#pragma unroll
                    for (int bj = 0; bj < 2; ++bj) { const f32x4 a0 = acc[ai][bj][m][0], a1 = acc[ai][bj][m][1];
                        u32x4 wv; wv.x = pk2(a0[0], a0[1]); wv.y = pk2(a0[2], a0[3]); wv.z = pk2(a1[0], a1[1]); wv.w = pk2(a1[2], a1[3]); *(u32x4*)(dst + (size_t)bj * 2 * S * HD) = wv; }
                    dst += dstep; OPQ(dst);
                }
                dst += 4 * dstep; OPQ(dst);
            }
        } else if (pn == 9) {
            bf16_t* dst = ub + (size_t)r0 * 256 + 32 * wc + 8 * fq;
#pragma unroll
            for (int ai = 0; ai < 2; ++ai) {
#pragma unroll
                for (int m = 0; m < 4; ++m) {
#pragma unroll
                    for (int bj = 0; bj < 2; ++bj) { const f32x4 a0 = acc[ai][bj][m][0], a1 = acc[ai][bj][m][1];
                        u32x4 wv; wv.x = pk2(a0[0], a0[1]); wv.y = pk2(a0[2], a0[3]); wv.z = pk2(a1[0], a1[1]); wv.w = pk2(a1[2], a1[3]); *(u32x4*)(dst + 128 * bj) = wv; }
                    dst += 16 * 256; OPQ(dst);
                }
                dst += 64 * 256; OPQ(dst);
            }
        } else {
            const int tg = pn - 10, wid = wr * 4 + wc, lane = fq * 16 + fr;
            unsigned char* dst = (unsigned char*)gates + ((size_t)(u.pm * 8 + tg) * 2) * 65536 + (wid * 64 + lane) * 16;
#pragma unroll
            for (int ai = 0; ai < 2; ++ai)
#pragma unroll
                for (int m = 0; m < 4; ++m) {
                    u32x4 w0, w1;
#pragma unroll
                    for (int n = 0; n < 2; ++n) {
                        const f32x4 a = acc[ai][0][m][n], b = acc[ai][1][m][n];
                        f32x4 ra, sp;
#pragma unroll
                        for (int j = 0; j < 4; ++j) { const float pa = 1.0f + __builtin_amdgcn_exp2f(fminf(a[j] * -1.4426950408889634f, 60.0f)), pb = 1.0f + __builtin_amdgcn_exp2f(fminf(b[j] * -1.4426950408889634f, 60.0f));
                            const float rr = __builtin_amdgcn_rcpf(pa * pb);
                            sp[j] = pa * rr; ra[j] = pb * pb * rr; }
                        w0[2 * n] = pk2(ra[0], ra[1]); w0[2 * n + 1] = pk2(ra[2], ra[3]); w1[2 * n] = pk2(sp[0], sp[1]); w1[2 * n + 1] = pk2(sp[2], sp[3]);
                    }
                    *(u32x4*)dst = w0; *(u32x4*)(dst + 65536) = w1;
                    dst += 8192; OPQ(dst);
                }
        }
    }
};

struct EpiGate2 {
    static constexpr bool PERM = true, AFTER_DRAIN = false, HAS_MID = true;
    const bf16_t* gates; bf16_t* merged;
    __device__ __forceinline__ void mid(f32x4 (&acc)[2][2][4][2], const pg8::Unit& u, int wr, int wc, int fr, int fq) const {
        const int wid = wr * 4 + wc, lane = fq * 16 + fr;
#pragma unroll
        for (int bj = 0; bj < 2; ++bj) {
            const unsigned char* gp = (const unsigned char*)gates + ((size_t)(u.pm * 8 + 2 * u.pn + bj) * 2) * 65536 + (wid * 64 + lane) * 16;
#pragma unroll
            for (int ai = 0; ai < 2; ++ai)
#pragma unroll
                for (int m = 0; m < 4; ++m) {
                    const u32x4 ga = __builtin_nontemporal_load((const u32x4*)gp);
#pragma unroll
                    for (int n = 0; n < 2; ++n) { f32x4 ra; ra[0] = bf2f(ga[2 * n] & 0xffffu); ra[1] = bf2f(ga[2 * n] >> 16); ra[2] = bf2f(ga[2 * n + 1] & 0xffffu); ra[3] = bf2f(ga[2 * n + 1] >> 16);
                        acc[ai][bj][m][n] = acc[ai][bj][m][n] * ra; }
                    gp += 8192; OPQ(gp);
                }
        }
    }
    __device__ __forceinline__ void operator()(const f32x4 (&acc)[2][2][4][2], const pg8::Unit& u, int wr, int wc, int fr, int fq) const {
        const int wid = wr * 4 + wc, lane = fq * 16 + fr;
        const int r0 = u.pm * 256 + wr * 64 + fr, c0 = u.pn * 256 + 32 * wc + 8 * fq;
#pragma unroll
        for (int bj = 0; bj < 2; ++bj) {
            const unsigned char* gp = (const unsigned char*)gates + ((size_t)(u.pm * 8 + 2 * u.pn + bj) * 2 + 1) * 65536 + (wid * 64 + lane) * 16;
            bf16_t* mp = merged + (size_t)r0 * D + c0 + 128 * bj;
#pragma unroll
            for (int ai = 0; ai < 2; ++ai) {
#pragma unroll
                for (int m = 0; m < 4; ++m) {
                    const u32x4 gw = __builtin_nontemporal_load((const u32x4*)gp);
                    u32x4 wv;
#pragma unroll
                    for (int n = 0; n < 2; ++n) { f32x4 g; g[0] = bf2f(gw[2 * n] & 0xffffu); g[1] = bf2f(gw[2 * n] >> 16); g[2] = bf2f(gw[2 * n + 1] & 0xffffu); g[3] = bf2f(gw[2 * n + 1] >> 16);
                        const f32x4 o = acc[ai][bj][m][n] * g; wv[2 * n] = pk2(o[0], o[1]); wv[2 * n + 1] = pk2(o[2], o[3]); }
                    *(u32x4*)mp = wv;
                    gp += 8192; OPQ(gp);
                    mp += 16 * D; OPQ(mp);
                }
                mp += 64 * D; OPQ(mp);
            }
        }
    }
};

struct EpiF32 {
    static constexpr bool PERM = false, AFTER_DRAIN = false, HAS_MID = false;
    float* out; int ldc;
    __device__ __forceinline__ void operator()(const f32x4 (&acc)[2][2][4][2], const pg8::Unit& u, int wr, int wc, int fr, int fq) const {
        float* op = out + (size_t)(u.pm * 256 + wr * 64 + fr) * ldc + u.pn * 256 + 32 * wc + 4 * fq;
#pragma unroll
        for (int ai = 0; ai < 2; ++ai) {
#pragma unroll
            for (int m = 0; m < 4; ++m) {
#pragma unroll
                for (int bj = 0; bj < 2; ++bj)
#pragma unroll
                    for (int n = 0; n < 2; ++n) *(f32x4*)(op + 128 * bj + 16 * n) = acc[ai][bj][m][n];
                op += 16 * (size_t)ldc; OPQ(op);
            }
            op += 64 * (size_t)ldc; OPQ(op);
        }
    }
};

struct EpiSwiglu {
    static constexpr bool PERM = true, AFTER_DRAIN = false, HAS_MID = false;
    bf16_t* act;
    __device__ __forceinline__ void operator()(const f32x4 (&acc)[2][2][4][2], const pg8::Unit& u, int wr, int wc, int fr, int fq) const {
        bf16_t* op = act + (size_t)(u.pm * 256 + wr * 64 + fr) * FFH + u.pn * 128 + 32 * wc + 8 * fq;
#pragma unroll
        for (int ai = 0; ai < 2; ++ai) {
#pragma unroll
            for (int m = 0; m < 4; ++m) {
                u32x4 wv;
#pragma unroll
                for (int n = 0; n < 2; ++n) {
                    const f32x4 a = acc[ai][0][m][n], b = acc[ai][1][m][n];
                    f32x4 o;
#pragma unroll
                    for (int j = 0; j < 4; ++j) o[j] = a[j] * sigmoidf_(a[j]) * b[j];
                    wv[2 * n] = pk2(o[0], o[1]); wv[2 * n + 1] = pk2(o[2], o[3]);
                }
                __builtin_nontemporal_store(wv, (u32x4*)op);
                op += 16 * FFH; OPQ(op);
            }
            op += 64 * FFH; OPQ(op);
        }
    }
};

struct RowStats {
    unsigned* xbuf;
    unsigned* cnt;
    __device__ __forceinline__ void run(const f32x4 (&v)[2][2][4][2], const pg8::Unit& u, int wr, int wc, int fr, int fq, LAS unsigned char* lds, int wid, int lane) const {
        LAS float* P = (LAS float*)lds;
        LAS float* Sg = (LAS float*)(lds + 8192);
#pragma unroll
        for (int ai = 0; ai < 2; ++ai)
#pragma unroll
            for (int m = 0; m < 4; ++m) {
                float q = 0.f;
#pragma unroll
                for (int bj = 0; bj < 2; ++bj)
#pragma unroll
                    for (int n = 0; n < 2; ++n) { const f32x4 d = v[ai][bj][m][n]; q += (d[0] * d[0] + d[1] * d[1]) + (d[2] * d[2] + d[3] * d[3]); }
                q += __shfl_xor(q, 16); q += __shfl_xor(q, 32);
                if (fq == 0) P[(ai * 128 + wr * 64 + m * 16 + fr) * 4 + wc] = q;
            }
        asm volatile("s_waitcnt lgkmcnt(0)" ::: "memory"); __builtin_amdgcn_s_barrier(); asm volatile("" ::: "memory");
        const int row = wid * 32 + (lane & 31);
        if (lane < 32) {
            const float tot = (P[row * 4 + 0] + P[row * 4 + 1]) + (P[row * 4 + 2] + P[row * 4 + 3]);
            __hip_atomic_store(xbuf + ((size_t)(u.pm * 256 + row) * 4 + u.pn), __builtin_bit_cast(unsigned, tot), __ATOMIC_RELAXED, __HIP_MEMORY_SCOPE_AGENT);
        }
        asm volatile("s_waitcnt vmcnt(0)" ::: "memory");
        if (lane == 0) __hip_atomic_fetch_add(cnt + 64 * u.pm, 1u, __ATOMIC_RELAXED, __HIP_MEMORY_SCOPE_AGENT);
        if (wid == 0) {
            unsigned spins = 0;
            while ((unsigned)__builtin_amdgcn_readfirstlane(__hip_atomic_load(cnt + 64 * u.pm, __ATOMIC_RELAXED, __HIP_MEMORY_SCOPE_AGENT)) < 32u) {
                __builtin_amdgcn_s_sleep(2); if (++spins > (1u << 22)) break; }
            __builtin_amdgcn_fence(__ATOMIC_ACQUIRE, "agent");
        }
        asm volatile("s_waitcnt vmcnt(0) lgkmcnt(0)" ::: "memory"); __builtin_amdgcn_s_barrier(); asm volatile("" ::: "memory");
        if (lane < 32) {
            const unsigned* slot = xbuf + (size_t)(u.pm * 256 + row) * 4; float t[4];
#pragma unroll
            for (int k = 0; k < 4; ++k) t[k] = __builtin_bit_cast(float, __hip_atomic_load(slot + k, __ATOMIC_RELAXED, __HIP_MEMORY_SCOPE_AGENT));
            Sg[row] = 1.0f / sqrtf(((t[0] + t[1]) + (t[2] + t[3])) * (1.0f / D) + EPS);
        }
        asm volatile("s_waitcnt lgkmcnt(0)" ::: "memory"); __builtin_amdgcn_s_barrier(); asm volatile("" ::: "memory");
    }
};
struct EpiRmsResRms {
    static constexpr bool PERM = true, AFTER_DRAIN = true, HAS_MID = false;
    const float* base; bf16_t* x1b; bf16_t* xn; const float* g1; const float* g2; RowStats st1, st2;
    __device__ __forceinline__ void fused(f32x4 (&acc)[2][2][4][2], const pg8::Unit& u, int wr, int wc, int fr, int fq, LAS unsigned char* lds, int wid, int lane) const {
        const LAS float* Sg = (const LAS float*)(lds + 8192);
        const int col0 = u.pn * 256 + wc * 32 + 8 * fq;
        const float* bp = base + (size_t)(u.pm * 256 + wr * 64 + fr) * D + col0;
        f32x4 pre[4][2][2];
#pragma unroll
        for (int m = 0; m < 4; ++m)
#pragma unroll
            for (int bj = 0; bj < 2; ++bj)
#pragma unroll
                for (int n = 0; n < 2; ++n) pre[m][bj][n] = __builtin_nontemporal_load((const f32x4*)(bp + (size_t)m * 16 * D + bj * 128 + n * 4));
        st1.run(acc, u, wr, wc, fr, fq, lds, wid, lane);
        {
            f32x4 gv[2][2];
#pragma unroll
            for (int bj = 0; bj < 2; ++bj)
#pragma unroll
                for (int n = 0; n < 2; ++n) gv[bj][n] = *(const f32x4*)(g1 + col0 + bj * 128 + n * 4);
#pragma unroll
            for (int ai = 0; ai < 2; ++ai) {
#pragma unroll
                for (int m = 0; m < 4; ++m) {
                    const float r1 = Sg[ai * 128 + wr * 64 + m * 16 + fr];
#pragma unroll
                    for (int bj = 0; bj < 2; ++bj)
#pragma unroll
                        for (int n = 0; n < 2; ++n) { const f32x4 bs = pre[m][bj][n]; acc[ai][bj][m][n] = bs + acc[ai][bj][m][n] * r1 * gv[bj][n]; }
                    if (ai == 0) {
#pragma unroll
                        for (int bj = 0; bj < 2; ++bj)
#pragma unroll
                            for (int n = 0; n < 2; ++n) pre[m][bj][n] = __builtin_nontemporal_load((const f32x4*)(bp + (size_t)128 * D + bj * 128 + n * 4));
                    }
                    asm volatile("" : "+v"(acc[ai][0][m][0]), "+v"(acc[ai][0][m][1]), "+v"(acc[ai][1][m][0]), "+v"(acc[ai][1][m][1]));
                    bp += 16 * D; OPQ(bp);
                    if (m & 1) asm volatile("" ::: "memory");
                }
                bp += 64 * D; OPQ(bp);
            }
        }
        st2.run(acc, u, wr, wc, fr, fq, lds, wid, lane);
        {
            f32x4 gv[2][2];
#pragma unroll
            for (int bj = 0; bj < 2; ++bj)
#pragma unroll
                for (int n = 0; n < 2; ++n) gv[bj][n] = *(const f32x4*)(g2 + col0 + bj * 128 + n * 4);
            bf16_t* op = x1b + (size_t)(u.pm * 256 + wr * 64 + fr) * D + col0; bf16_t* xp = xn + (size_t)(u.pm * 256 + wr * 64 + fr) * D + col0;
#pragma unroll
            for (int ai = 0; ai < 2; ++ai) {
#pragma unroll
                for (int m = 0; m < 4; ++m) {
                    const float r2 = Sg[ai * 128 + wr * 64 + m * 16 + fr];
#pragma unroll
                    for (int bj = 0; bj < 2; ++bj) { u32x4 wx, wv;
#pragma unroll
                        for (int n = 0; n < 2; ++n) { const f32x4 x1 = acc[ai][bj][m][n]; wx[2 * n] = pk2(x1[0], x1[1]); wx[2 * n + 1] = pk2(x1[2], x1[3]);
                            const f32x4 o = x1 * r2 * gv[bj][n]; wv[2 * n] = pk2(o[0], o[1]); wv[2 * n + 1] = pk2(o[2], o[3]); }
                        *(u32x4*)(op + bj * 128) = wx; *(u32x4*)(xp + bj * 128) = wv; }
                    op += 16 * D; xp += 16 * D; OPQ(op); OPQ(xp);
                }
                op += 64 * D; xp += 64 * D; OPQ(op); OPQ(xp);
            }
        }
    }
};
struct EpiRmsRes {
    static constexpr bool PERM = true, AFTER_DRAIN = true, HAS_MID = false;
    const bf16_t* x1b; float* out; const float* g1; RowStats st;
    __device__ __forceinline__ void fused(f32x4 (&acc)[2][2][4][2], const pg8::Unit& u, int wr, int wc, int fr, int fq, LAS unsigned char* lds, int wid, int lane) const {
        const LAS float* Sg = (const LAS float*)(lds + 8192);
        const int col0 = u.pn * 256 + wc * 32 + 8 * fq;
        const bf16_t* bp = x1b + (size_t)(u.pm * 256 + wr * 64 + fr) * D + col0; float* op = out + (size_t)(u.pm * 256 + wr * 64 + fr) * D + col0;
        u32x4 pre[2][4][2];
#pragma unroll
        for (int ai = 0; ai < 2; ++ai)
#pragma unroll
            for (int m = 0; m < 4; ++m)
#pragma unroll
                for (int bj = 0; bj < 2; ++bj) pre[ai][m][bj] = *(const u32x4*)(bp + (size_t)(ai * 128 + m * 16) * D + bj * 128);
        st.run(acc, u, wr, wc, fr, fq, lds, wid, lane);
        f32x4 gv[2][2];
#pragma unroll
        for (int bj = 0; bj < 2; ++bj)
#pragma unroll
            for (int n = 0; n < 2; ++n) gv[bj][n] = *(const f32x4*)(g1 + col0 + bj * 128 + n * 4);
#pragma unroll
        for (int ai = 0; ai < 2; ++ai) {
#pragma unroll
            for (int m = 0; m < 4; ++m) {
                const float r1 = Sg[ai * 128 + wr * 64 + m * 16 + fr];
#pragma unroll
                for (int bj = 0; bj < 2; ++bj)
#pragma unroll
                    for (int n = 0; n < 2; ++n) { const unsigned px = pre[ai][m][bj][2 * n], py = pre[ai][m][bj][2 * n + 1]; f32x4 bs; bs[0] = bf2f(px & 0xffffu); bs[1] = bf2f(px >> 16); bs[2] = bf2f(py & 0xffffu); bs[3] = bf2f(py >> 16);
                        *(f32x4*)(op + bj * 128 + n * 4) = bs + acc[ai][bj][m][n] * r1 * gv[bj][n]; }
                op += 16 * D; OPQ(op);
            }
            op += 64 * D; OPQ(op);
        }
    }
};

template <int MAP> __device__ __forceinline__ int src_col(int s) {
    if (MAP == 1) s = in_tile(s >> 8) * 256 + (s & 255);
    if (MAP == 1) { if (s < 1536) { const int bj = (s >> 7) & 1, wc = (s >> 5) & 3, rest = s & 31; return (s & ~255) + 64 * wc + 32 * bj + rest; }
                    if (s >= 2560) { const int tg = (s - 2560) >> 8, bj = (s >> 7) & 1, cc = s & 127; return 2560 + bj * 1024 + 128 * tg + cc; } return s; }
    if (MAP == 2) { const int pn = s >> 8, bj = (s >> 7) & 1, cc = s & 127; return bj * FFH + 128 * pn + cc; }
    return s;
}
template <int MAP> __device__ __forceinline__ void transpose_item(const float* W, int K, int N, bf16_t* WT, LAS float* scr, int item, int lane, int ldk = 0) {
    const int nblk = N / 32, kb = item / nblk, nb = item % nblk, k0 = 64 * kb, n0 = 32 * nb;
    const int sc = src_col<MAP>(n0 + (lane & 31));
    float tv[32];
#pragma unroll
    for (int i = 0; i < 32; ++i) tv[i] = W[(size_t)(k0 + 2 * i + (lane >> 5)) * N + sc];
#pragma unroll
    for (int i = 0; i < 32; ++i) scr[(2 * i + (lane >> 5)) * 33 + (lane & 31)] = tv[i];
    asm volatile("s_waitcnt lgkmcnt(0)" ::: "memory");
    const int c = lane & 7;
#pragma unroll
    for (int j = 0; j < 4; ++j) { const int n = (lane >> 3) + 8 * j; const LAS float* s = scr + (8 * c) * 33 + n;
        u32x4 o; o.x = pk2(s[0 * 33], s[1 * 33]); o.y = pk2(s[2 * 33], s[3 * 33]); o.z = pk2(s[4 * 33], s[5 * 33]); o.w = pk2(s[6 * 33], s[7 * 33]);
        *(u32x4*)(WT + (size_t)(n0 + n) * (ldk ? ldk : K) + k0 + 8 * c) = o; }
    asm volatile("s_waitcnt lgkmcnt(0)" ::: "memory");
}

template <int MAP> __device__ __forceinline__ void transpose_sub(const float* W, int K, int N, bf16_t* WT, LAS float* scr, int item, int sub, int lane) {
    const int nblk = N / 32, kb = item / nblk, nb = item % nblk, k0 = 64 * kb + 8 * sub, n0 = 32 * nb;
    const int sc = src_col<MAP>(n0 + (lane & 31));
    float tv[4];
#pragma unroll
    for (int i = 0; i < 4; ++i) tv[i] = W[(size_t)(k0 + 2 * i + (lane >> 5)) * N + sc];
#pragma unroll
    for (int i = 0; i < 4; ++i) scr[(2 * i + (lane >> 5)) * 33 + (lane & 31)] = tv[i];
    asm volatile("s_waitcnt lgkmcnt(0)" ::: "memory");
    if (lane < 32) { const LAS float* sp = scr + lane;
        u32x4 o; o.x = pk2(sp[0 * 33], sp[1 * 33]); o.y = pk2(sp[2 * 33], sp[3 * 33]); o.z = pk2(sp[4 * 33], sp[5 * 33]); o.w = pk2(sp[6 * 33], sp[7 * 33]);
        *(u32x4*)(WT + (size_t)(n0 + lane) * K + k0) = o; }
    asm volatile("s_waitcnt lgkmcnt(0)" ::: "memory");
}

template <int W> __device__ __forceinline__ void pool_unit(const bf16_t* Ub, const bf16_t* WmT, const float* pool_scale, bf16_t* YP, int tt, int g, int c, int q) {
    const int t = 16 * tt + c;
    const int cnt = (t + 1 < W) ? t + 1 : W; const float rc = 1.0f / (float)cnt;
    bf16x8 zf[2];
#pragma unroll
    for (int kc = 0; kc < 2; ++kc) {
        const bf16_t* up = Ub + (size_t)t * 256 + g * 64 + 32 * kc + 8 * q;
        u32x4 v[W];
#pragma unroll
        for (int i = 0; i < W; ++i) { const int ti = (i <= t) ? i : 0; v[i] = *(const u32x4*)(up - (size_t)ti * 256); }
        float sum[8];
#pragma unroll
        for (int e = 0; e < 8; ++e) sum[e] = 0.f;
#pragma unroll
        for (int i = 0; i < W; ++i) { const float wgt = (i <= t) ? 1.0f : 0.0f;
#pragma unroll
            for (int e = 0; e < 4; ++e) { sum[2 * e] += wgt * bf2f(v[i][e] & 0xffffu); sum[2 * e + 1] += wgt * bf2f(v[i][e] >> 16); } }
        u32x4 zw;
#pragma unroll
        for (int e = 0; e < 4; ++e) zw[e] = pk2(sum[2 * e] * rc - bf2f(v[0][e] & 0xffffu), sum[2 * e + 1] * rc - bf2f(v[0][e] >> 16));
        zf[kc] = __builtin_bit_cast(bf16x8, zw);
    }
#pragma unroll
    for (int dt = 0; dt < 4; ++dt) {
        const bf16_t* wp = WmT + (size_t)g * 4096 + (16 * dt + c) * 64 + 8 * q;
        const bf16x8 a0 = *(const bf16x8*)wp, a1 = *(const bf16x8*)(wp + 32);
        f32x4 a = (f32x4){0.f, 0.f, 0.f, 0.f};
        a = __builtin_amdgcn_mfma_f32_16x16x32_bf16(a0, zf[0], a, 0, 0, 0);
        a = __builtin_amdgcn_mfma_f32_16x16x32_bf16(a1, zf[1], a, 0, 0, 0);
        const f32x4 scl = *(const f32x4*)(pool_scale + g * 64 + 16 * dt + 4 * q);
        u32x2 wv; wv.x = pk2(a[0] * scl[0], a[1] * scl[1]); wv.y = pk2(a[2] * scl[2], a[3] * scl[3]);
        *(u32x2*)(YP + (size_t)t * 512 + 256 + g * 64 + 16 * dt + 4 * q) = wv;
    }
}

#define XB_TMO      128
#define XB_XCNT(j)  (256  + 64 * (j))
#define XB_XSUB(j)  (1280 + 64 * (j))
#define XB_XGEN(j)  (2304 + 64 * (j))
#define XB_TOP      3328
#define XB_TOPGEN   3392
#define XCD_BAR_WORDS 3456
#define XB_SPIN_CAP (1u << 18)

__device__ __forceinline__ unsigned xb_ld(unsigned* p)              { return __hip_atomic_load(p, __ATOMIC_RELAXED, __HIP_MEMORY_SCOPE_AGENT); }
__device__ __forceinline__ unsigned xb_add(unsigned* p, unsigned v) { return __hip_atomic_fetch_add(p, v, __ATOMIC_RELAXED, __HIP_MEMORY_SCOPE_AGENT); }
__device__ __forceinline__ unsigned xb_xcc_id() { return (unsigned)__builtin_amdgcn_s_getreg((3 << 11) | 20) & 0xFu; }
#define XB_SPIN(cond, bar) do { unsigned _sp = 0; while (cond) { __builtin_amdgcn_s_sleep(1); \
    if ((++_sp & 255u) == 0u) { if (xb_ld(&(bar)[XB_TMO])) break; if (_sp > XB_SPIN_CAP) { atomicAdd(&(bar)[XB_TMO], 1u); break; } } } } while (0)

struct XcdBarrier {
    unsigned* bar; unsigned x;
    volatile LAS unsigned* st;
};

__device__ __forceinline__ XcdBarrier xcd_barrier_post(unsigned* bar, volatile LAS unsigned* st) {
    XcdBarrier b; b.bar = bar; b.x = xb_xcc_id(); b.st = st;
    if (threadIdx.x == 0) (void)xb_add(&bar[XB_XCNT(b.x)], 1u);
    return b;
}
__device__ __forceinline__ void xcd_barrier_complete(unsigned* bar, unsigned x, unsigned& nloc, unsigned& nx) {
    const unsigned G = gridDim.x * gridDim.y * gridDim.z;
    unsigned sum, cnt, mine, sp = 0u;
    for (;;) {
        sum = 0u; cnt = 0u; mine = 0u;
#pragma unroll
        for (unsigned j = 0; j < 16; ++j) { const unsigned c = xb_ld(&bar[XB_XCNT(j)]); sum += c; cnt += (c > 0u) ? 1u : 0u; mine = (j == x) ? c : mine; }
        if (sum == G) break;
        __builtin_amdgcn_s_sleep(1);
        if ((++sp & 255u) == 0u) { if (xb_ld(&bar[XB_TMO])) break; if (sp > XB_SPIN_CAP) { atomicAdd(&bar[XB_TMO], 1u); break; } }
    }
    nloc = mine > 0u ? mine : 1u; nx = cnt > 0u ? cnt : 1u;
}

__device__ __forceinline__ void xcd_barrier(const XcdBarrier& b) {
    asm volatile("s_waitcnt vmcnt(0)" ::: "memory");
    __syncthreads();
    if (threadIdx.x == 0) {
        unsigned* bar = b.bar;
        __builtin_amdgcn_s_waitcnt(0);
        unsigned nloc = b.st[0], nx = b.st[1];
        if (nloc == 0u) { xcd_barrier_complete(bar, b.x, nloc, nx); b.st[0] = nloc; b.st[1] = nx; }
        const unsigned old = xb_add(&bar[XB_XSUB(b.x)], 1u);
        const unsigned gen = old / nloc;
        if (old + 1u == (gen + 1u) * nloc) {
            __builtin_amdgcn_fence(__ATOMIC_RELEASE, "agent");
            asm volatile("s_waitcnt vmcnt(0)" ::: "memory");
            const unsigned og = xb_add(&bar[XB_TOP], 1u);
            const unsigned tg = og / nx;
            if (og + 1u == (tg + 1u) * nx) xb_add(&bar[XB_TOPGEN], 1u);
            else XB_SPIN(xb_ld(&bar[XB_TOPGEN]) == tg, bar);
            __builtin_amdgcn_fence(__ATOMIC_ACQUIRE, "agent");
            xb_add(&bar[XB_XGEN(b.x)], 1u);
            asm volatile("s_waitcnt vmcnt(0)" ::: "memory");
        } else {
            XB_SPIN(xb_ld(&bar[XB_XGEN(b.x)]) == gen, bar);
            __builtin_amdgcn_fence(__ATOMIC_ACQUIRE, "agent");
            asm volatile("s_waitcnt vmcnt(0)" ::: "memory");
        }
    }
    __syncthreads();
}


struct Args { const float* in[13]; float* out; unsigned char* ws; float invf[32]; int lo, hi; };

__global__ void __launch_bounds__(512, 2) fwd_mega(Args args) {
    extern __shared__ __attribute__((aligned(16))) unsigned char lds_raw[];
    LAS unsigned char* lds = (LAS unsigned char*)lds_raw;
    cg::grid_group grid = cg::this_grid();
    const int wave = __builtin_amdgcn_readfirstlane((int)threadIdx.x >> 6);
#define LANE_TID() const int lane = lane_id_asm(), tid = wave * 64 + lane
    const int G = gridDim.x, gw = blockIdx.x * 8 + wave, NGW = G * 8;
    const int lo = args.lo, hi = args.hi;
    volatile LAS unsigned* MISC = (volatile LAS unsigned*)(lds + 131072);
    if (threadIdx.x < 2) MISC[threadIdx.x] = 0u;
    __syncthreads();
    if (hi > NPHASE + 1) grid.sync();
    const XcdBarrier xbar = xcd_barrier_post((unsigned*)(args.ws + WS_CTL) + CW_XBAR, MISC);
#define IN(k) (lo <= (k) && (k) < hi)
#define WSP(T, off) ((T*)(args.ws + (off)))
#define SEAM(k) do { if (IN(k) && IN((k) + 1)) xcd_barrier(xbar); } while (0)

    for (int rep_ = 0; rep_ < NREP(0); ++rep_) { if (rep_) xcd_barrier(xbar);
    if (IN(0)) {
        LANE_TID(); (void)tid;
        LAS float* scr = (LAS float*)(lds + wave * 16384);
        const float* x = args.in[0]; const float* g_pre_mix = args.in[1]; const float* w_in = args.in[2];
        bf16_t* WinT = WSP(bf16_t, WS_WIN); float* tab = WSP(float, WS_TAB); bf16_t* Hb = WSP(bf16_t, WS_H);
        constexpr int I_IN = (D / 64) * (NIN / 32);
        {
            const int nfull = (I_IN / NGW) * NGW;
            for (int it = gw; it < nfull; it += NGW) transpose_item<1>(w_in, D, NIN, WinT, scr, it, lane);
            for (int it = nfull + (int)blockIdx.x; it < I_IN; it += G) transpose_sub<1>(w_in, D, NIN, WinT, scr, it, wave, lane);
        }
        for (int e = blockIdx.x * 512 + tid; e < S * 32; e += G * 512) {
            const int pos = e >> 5, f = e & 31;
            const float ang = (float)pos * args.invf[f];
            const double rev = (double)ang * 0.15915494309189535;
            const float fr = (float)(rev - floor(rev));
            tab[2 * e] = __builtin_amdgcn_cosf(fr); tab[2 * e + 1] = __builtin_amdgcn_sinf(fr);
        }
        {
            f32x4 gq[4];
#pragma unroll
            for (int j = 0; j < 4; ++j) gq[j] = ((const f32x4*)g_pre_mix)[lane + 64 * j];
            for (int m = gw; m < S; m += 2 * NGW) {
                const int m2 = m + NGW;
                const f32x4* xa = (const f32x4*)(x + (size_t)m * D) + lane; const f32x4* xb = (const f32x4*)(x + (size_t)(m2 < S ? m2 : m) * D) + lane;
                f32x4 va[4], vb[4]; float sa = 0.f, sb = 0.f;
#pragma unroll
                for (int j = 0; j < 4; ++j) { va[j] = xa[64 * j]; vb[j] = xb[64 * j]; }
#pragma unroll
                for (int j = 0; j < 4; ++j) { sa += (va[j][0] * va[j][0] + va[j][1] * va[j][1]) + (va[j][2] * va[j][2] + va[j][3] * va[j][3]); sb += (vb[j][0] * vb[j][0] + vb[j][1] * vb[j][1]) + (vb[j][2] * vb[j][2] + vb[j][3] * vb[j][3]); }
                const float ra = 1.0f / sqrtf(wave_sum(sa) * (1.0f / D) + EPS), rb = 1.0f / sqrtf(wave_sum(sb) * (1.0f / D) + EPS);
                u32x2* oa = (u32x2*)(Hb + (size_t)m * D) + lane; u32x2* ob = (u32x2*)(Hb + (size_t)m2 * D) + lane;
#pragma unroll
                for (int j = 0; j < 4; ++j) { u32x2 w; w.x = pk2(va[j][0] * ra * gq[j][0], va[j][1] * ra * gq[j][1]); w.y = pk2(va[j][2] * ra * gq[j][2], va[j][3] * ra * gq[j][3]); oa[64 * j] = w; }
                if (m2 < S) {
#pragma unroll
                    for (int j = 0; j < 4; ++j) { u32x2 w; w.x = pk2(vb[j][0] * rb * gq[j][0], vb[j][1] * rb * gq[j][1]); w.y = pk2(vb[j][2] * rb * gq[j][2], vb[j][3] * rb * gq[j][3]); ob[64 * j] = w; }
                }
            }
        }
    } }
    SEAM(0);

    for (int rep_ = 0; rep_ < NREP(1); ++rep_) { if (rep_) xcd_barrier(xbar);
    if (IN(1)) {
        LANE_TID(); (void)tid;
        pg8::Gemm g{WSP(bf16_t, WS_H), WSP(bf16_t, WS_WIN), S, NIN, D}; pg8::StaticOrder So; So.init(S, NIN, G, (int)blockIdx.x);
        EpiIn E{WSP(bf16_t, WS_QKV), WSP(bf16_t, WS_U), WSP(bf16_t, WS_GATES), WSP(float, WS_TAB)};
        pg8::gemm_phase<EpiIn, pg8::StaticOrder, true, true>(lds, g, So, E, wave, lane);
        {
            const int nwg = (S / 256) * (NIN / 256), rem = nwg % G;
            const bool helper = (rem == 0) || ((int)blockIdx.x >= rem);
            if (helper) {
                const int nh = (rem == 0) ? G : G - rem, hid = (rem == 0) ? (int)blockIdx.x : (int)blockIdx.x - rem;
                const float* w_mix = args.in[3]; const float* w_pa = args.in[5]; const float* w_pp = args.in[6]; const float* w_out = args.in[7]; const float* w_gu = args.in[10]; const float* w_down = args.in[11];
                bf16_t* WpaT = WSP(bf16_t, WS_WPA); bf16_t* WoutT = WSP(bf16_t, WS_WOUT); bf16_t* WguT = WSP(bf16_t, WS_WGU); bf16_t* WdT = WSP(bf16_t, WS_WD); bf16_t* WmT = WSP(bf16_t, WS_WMT);
                LAS float* scr = (LAS float*)(lds + wave * 16384);
                constexpr int I_PA = (256 / 64) * (D / 32), I_OUT = (D / 64) * (D / 32), I_GU = (D / 64) * (NGU / 32), I_DN = (FFH / 64) * (D / 32), I_MX = 4 * 2;
                constexpr int NDEF = 2 * I_PA + I_OUT + I_GU + I_DN + I_MX;
                for (int it = hid * 8 + wave; it < NDEF; it += nh * 8) {
                    int r = it;
                    if (r < I_MX) { const int gg = r >> 1; transpose_item<0>(w_mix + gg * 4096, 64, 64, WmT + gg * 4096, scr, r & 1, lane); continue; } r -= I_MX;
                    if (r < I_PA) { transpose_item<0>(w_pa, 256, D, WpaT, scr, r, lane, 512); continue; } r -= I_PA;
                    if (r < I_PA) { transpose_item<0>(w_pp, 256, D, WpaT + 256, scr, r, lane, 512); continue; } r -= I_PA;
                    if (r < I_OUT) { transpose_item<0>(w_out, D, D, WoutT, scr, r, lane); continue; } r -= I_OUT;
                    if (r < I_GU) { transpose_item<2>(w_gu, D, NGU, WguT, scr, r, lane); continue; } r -= I_GU;
                    transpose_item<0>(w_down, FFH, D, WdT, scr, r, lane);
                }
            }
        }
    } }
    SEAM(1);

    for (int rep_ = 0; rep_ < NREP(2); ++rep_) { if (rep_) xcd_barrier(xbar);
    if (IN(2)) {
        LANE_TID(); (void)tid;
        constexpr int RS = 192, NU = NHEAD * 128;
        const bf16_t* QKV = WSP(bf16_t, WS_QKV); const bf16_t* Ub = WSP(bf16_t, WS_U); bf16_t* OG = WSP(bf16_t, WS_OG); float* LSE = WSP(float, WS_LSE); bf16_t* YP = WSP(bf16_t, WS_OA);
        const bf16_t* WmT = WSP(bf16_t, WS_WMT); const float* pool_scale = args.in[4];
        LAS unsigned char* Kl = lds; LAS unsigned char* Vl = lds + 272 * RS;
        const int c = lane & 15, q = lane >> 4;
        const int rq = tid >> 3, ch = tid & 7, chs = ch ^ ((rq >> 2) & 3);
        for (int i = tid; i < 2 * 768; i += 512) { LAS unsigned char* base = (i < 768) ? Kl : Vl; const int j = (i < 768) ? i : i - 768; *(LAS unsigned*)(base + 256 * RS + 4 * j) = 0u; }
#define AU_OF(un_, h_, row0_, sh_, first_) const int h_ = (un_) >> 7, row0_ = ((un_) & 127) * 128, sh_ = 2 * (h_ >> 2); const bool first_ = (row0_ & ((S >> sh_) - 1)) == 0
#define KV_LOAD(kv, h_, row0_, first_) do { const bf16_t* pk_ = QKV + ((size_t)(NHEAD + (h_)) * S + ((row0_) - 128 + rq)) * HD + 8 * ch; const bf16_t* pv_ = QKV + ((size_t)(2 * NHEAD + (h_)) * S + ((row0_) - 128 + rq)) * HD + 8 * ch; \
            _Pragma("unroll") for (int i_ = 0; i_ < 4; ++i_) { if (i_ >= 2 || !(first_)) { kv[i_] = *(const u32x4*)(pk_ + (size_t)i_ * 64 * HD); kv[4 + i_] = *(const u32x4*)(pv_ + (size_t)i_ * 64 * HD); } \
                else { kv[i_] = (u32x4){0u, 0u, 0u, 0u}; kv[4 + i_] = (u32x4){0u, 0u, 0u, 0u}; } } } while (0)
#define KV_WRITE(kv) do { _Pragma("unroll") for (int i_ = 0; i_ < 4; ++i_) { *(LAS u32x4*)(Kl + (64 * i_ + rq) * RS + chs * 16) = kv[i_]; *(LAS u32x4*)(Vl + (64 * i_ + rq) * RS + chs * 16) = kv[4 + i_]; } } while (0)
#define Q_LOAD(qf, h_, row0_) do { const bf16_t* Qp_ = QKV + ((size_t)(h_) * S + ((row0_) + 16 * wave + c)) * HD + 8 * q; qf[0] = *(const bf16x8*)Qp_; qf[1] = *(const bf16x8*)(Qp_ + 32); } while (0)
        typedef short s16x4 __attribute__((ext_vector_type(4)));
        u32x4 kv[8]; bf16x8 qf[2], qn[2];
        int un = blockIdx.x;
        if (un < NU) { AU_OF(un, h0, r0, s0, f0); (void)s0; KV_LOAD(kv, h0, r0, f0); Q_LOAD(qf, h0, r0); }
        for (; un < NU; un += G) {
            AU_OF(un, h, row0, sh, first);
            const int un2 = un + G; const bool has2 = un2 < NU;
            AU_OF((has2 ? un2 : un), h2, row2, sh2, first2); (void)sh2;
            __syncthreads();
            KV_WRITE(kv);
            __syncthreads();
            if (has2) { KV_LOAD(kv, h2, row2, first2); Q_LOAD(qn, h2, row2); }
            const int L = S >> sh;
            {
                const int qrow = row0 + 16 * wave + c;
                f32x4 sc[10];
#pragma unroll
                for (int t = 0; t < 10; ++t) {
                    const int krow = 16 * wave + 32 * (t >> 1) + 8 * (c >> 2) + 4 * (t & 1) + (c & 3);
                    const int kx = (q ^ ((2 * (c >> 2) + (t & 1)) & 3)) * 16;
                    const bf16x8 k0 = *(const LAS bf16x8*)(Kl + krow * RS + kx), k1 = *(const LAS bf16x8*)(Kl + krow * RS + 64 + kx);
                    f32x4 a = (f32x4){0.f, 0.f, 0.f, 0.f};
                    a = __builtin_amdgcn_mfma_f32_16x16x32_bf16(k0, qf[0], a, 0, 0, 0);
                    a = __builtin_amdgcn_mfma_f32_16x16x32_bf16(k1, qf[1], a, 0, 0, 0);
                    sc[t] = a;
                }
                const int ql = 128 + 16 * wave + c;
                float mx = -1e30f;
#pragma unroll
                for (int t = 0; t < 10; ++t)
#pragma unroll
                    for (int rg = 0; rg < 4; ++rg) {
                        const int kl = 16 * wave + 32 * (t >> 1) + 8 * q + 4 * (t & 1) + rg, dist = ql - kl;
                        const bool valid = dist >= 0 && dist <= 128 && (kl >= 128 || !first);
                        const float sv = valid ? sc[t][rg] * 0.18033688011112042f : -1e30f;
                        sc[t][rg] = sv; mx = fmaxf(mx, sv);
                    }
                mx = fmaxf(mx, __shfl_xor(mx, 16)); mx = fmaxf(mx, __shfl_xor(mx, 32));
                float lsum = 0.f;
#pragma unroll
                for (int t = 0; t < 10; ++t)
#pragma unroll
                    for (int rg = 0; rg < 4; ++rg) { const float pv = __builtin_amdgcn_exp2f(sc[t][rg] - mx); sc[t][rg] = pv; lsum += pv; }
                lsum += __shfl_xor(lsum, 16); lsum += __shfl_xor(lsum, 32);
                f32x4 o[4];
#pragma unroll
                for (int dt = 0; dt < 4; ++dt) o[dt] = (f32x4){0.f, 0.f, 0.f, 0.f};
#pragma unroll
                for (int cc = 0; cc < 5; ++cc) {
                    u32x4 pw; pw.x = pk2(sc[2 * cc][0], sc[2 * cc][1]); pw.y = pk2(sc[2 * cc][2], sc[2 * cc][3]); pw.z = pk2(sc[2 * cc + 1][0], sc[2 * cc + 1][1]); pw.w = pk2(sc[2 * cc + 1][2], sc[2 * cc + 1][3]);
                    const bf16x8 pf = __builtin_bit_cast(bf16x8, pw);
                    LAS unsigned char* vb = Vl + (16 * wave + 32 * cc + 8 * q + (c >> 2)) * RS + 8 * (c & 1);
                    const int px = (c >> 1) & 1, x0 = (2 * q) & 3, x1 = (2 * q + 1) & 3;
#pragma unroll
                    for (int dt = 0; dt < 4; ++dt) {
                        const s16x4 v0 = __builtin_bit_cast(s16x4, __builtin_amdgcn_ds_read_tr16_b64_v4i16((LAS s16x4*)(vb + 16 * ((2 * dt + px) ^ x0))));
                        const s16x4 v1 = __builtin_bit_cast(s16x4, __builtin_amdgcn_ds_read_tr16_b64_v4i16((LAS s16x4*)(vb + 4 * RS + 16 * ((2 * dt + px) ^ x1))));
                        bf16x8 vf; vf[0] = v0[0]; vf[1] = v0[1]; vf[2] = v0[2]; vf[3] = v0[3]; vf[4] = v1[0]; vf[5] = v1[1]; vf[6] = v1[2]; vf[7] = v1[3];
                        o[dt] = __builtin_amdgcn_mfma_f32_16x16x32_bf16(vf, pf, o[dt], 0, 0, 0);
                    }
                }
                const float inv = 1.0f / lsum;
                const int tok = ((qrow & (L - 1)) << sh) + (qrow >> (14 - sh));
                bf16_t* op = OG + ((size_t)h * S + tok) * HD + 4 * q;
#pragma unroll
                for (int dt = 0; dt < 4; ++dt) { u32x2 w; w.x = pk2(o[dt][0] * inv, o[dt][1] * inv); w.y = pk2(o[dt][2] * inv, o[dt][3] * inv); *(u32x2*)(op + 16 * dt) = w; }
                if (q == 0) LSE[(size_t)h * S + tok] = (mx + __log2f(lsum)) * 0.6931471805599453f;
            }
            qf[0] = qn[0]; qf[1] = qn[1];
        }
#undef AU_OF
#undef KV_LOAD
#undef KV_WRITE
#undef Q_LOAD
        for (int wu = gw; wu < (S / 16) * 4; wu += NGW) {
            const int tt = wu >> 2, g = wu & 3;
            if (g == 0) pool_unit<2>(Ub, WmT, pool_scale, YP, tt, 0, c, q);
            else if (g == 1) pool_unit<4>(Ub, WmT, pool_scale, YP, tt, 1, c, q);
            else if (g == 2) pool_unit<8>(Ub, WmT, pool_scale, YP, tt, 2, c, q);
            else pool_unit<16>(Ub, WmT, pool_scale, YP, tt, 3, c, q);
        }
    } }
    SEAM(2);

    for (int rep_ = 0; rep_ < NREP(3); ++rep_) { if (rep_) xcd_barrier(xbar);
    if (IN(3)) {
        LANE_TID(); (void)tid;
        const bf16_t* OG = WSP(bf16_t, WS_OG); const float* LSE = WSP(float, WS_LSE); bf16_t* OA = WSP(bf16_t, WS_OA);
        for (int e0 = blockIdx.x * 512 + tid; e0 < S * 32; e0 += 4 * G * 512) {
            float l0[4], l1[4], l2[4]; u32x4 v0[4], v1[4], v2[4];
#pragma unroll
            for (int k = 0; k < 4; ++k) {
                const int e = e0 + k * G * 512, ec = e < S * 32 ? e : e0;
                const int d8 = ec & 7, j = (ec >> 3) & 3, t = ec >> 5;
                l0[k] = LSE[(size_t)(0 + j) * S + t]; l1[k] = LSE[(size_t)(4 + j) * S + t]; l2[k] = LSE[(size_t)(8 + j) * S + t];
                v0[k] = *(const u32x4*)(OG + ((size_t)(0 + j) * S + t) * HD + 8 * d8); v1[k] = *(const u32x4*)(OG + ((size_t)(4 + j) * S + t) * HD + 8 * d8); v2[k] = *(const u32x4*)(OG + ((size_t)(8 + j) * S + t) * HD + 8 * d8);
            }
#pragma unroll
            for (int k = 0; k < 4; ++k) {
                const int e = e0 + k * G * 512;
                if (e < S * 32) {
                    const int d8 = e & 7, j = (e >> 3) & 3, t = e >> 5;
                    const float mx = fmaxf(l0[k], fmaxf(l1[k], l2[k]));
                    float w0 = __expf(l0[k] - mx), w1 = __expf(l1[k] - mx), w2 = __expf(l2[k] - mx);
                    const float inv = __builtin_amdgcn_rcpf(w0 + w1 + w2); w0 *= inv; w1 *= inv; w2 *= inv;
                    u32x4 o;
#pragma unroll
                    for (int i = 0; i < 4; ++i) {
                        const float a = w0 * bf2f(v0[k][i] & 0xffffu) + w1 * bf2f(v1[k][i] & 0xffffu) + w2 * bf2f(v2[k][i] & 0xffffu);
                        const float bb = w0 * bf2f(v0[k][i] >> 16) + w1 * bf2f(v1[k][i] >> 16) + w2 * bf2f(v2[k][i] >> 16);
                        o[i] = pk2(a, bb);
                    }
                    *(u32x4*)(OA + (size_t)t * 512 + 64 * j + 8 * d8) = o;
                }
            }
        }
    } }
    SEAM(3);

    for (int rep_ = 0; rep_ < NREP(4); ++rep_) { if (rep_) xcd_barrier(xbar);
    if (IN(4)) {
        LANE_TID(); (void)tid;
        int K1 = 512; asm volatile("" : "+s"(K1));
        pg8::Gemm g{WSP(bf16_t, WS_OA), WSP(bf16_t, WS_WPA), S, D, K1}; pg8::StaticOrder So; So.init(S, D, G, (int)blockIdx.x);
        EpiGate2 E{WSP(bf16_t, WS_GATES), WSP(bf16_t, WS_H)};
        pg8::gemm_phase<EpiGate2, pg8::StaticOrder, true, true>(lds, g, So, E, wave, lane);
    } }
    SEAM(4);

    { const int rep_ = 0; (void)rep_;
    if (IN(5)) {
        LANE_TID(); (void)tid;
        pg8::Gemm g{WSP(bf16_t, WS_H), WSP(bf16_t, WS_WOUT), S, D, D}; pg8::StaticOrder So; So.init(S, D, G, (int)blockIdx.x);
        RowStats st1{WSP(unsigned, WS_XBUF + (size_t)rep_ * 786432), WSP(unsigned, WS_CTL) + (rep_ ? 20480 : 1024)}; RowStats st2{WSP(unsigned, WS_XBUF + 262144 + (size_t)rep_ * 786432), WSP(unsigned, WS_CTL) + (rep_ ? 20480 : 1024) + 4096};
        EpiRmsResRms E{args.in[0], WSP(bf16_t, WS_X1), WSP(bf16_t, WS_H2), args.in[8], args.in[9], st1, st2};
        pg8::gemm_phase<EpiRmsResRms, pg8::StaticOrder, false, true>(lds, g, So, E, wave, lane);
    } }
    SEAM(5);

    for (int rep_ = 0; rep_ < NREP(7); ++rep_) { if (rep_) xcd_barrier(xbar);
    if (IN(7)) {
        LANE_TID(); (void)tid;
        pg8::Gemm g{WSP(bf16_t, WS_H2), WSP(bf16_t, WS_WGU), S, NGU, D}; pg8::StaticOrder So; So.init(S, NGU, G, (int)blockIdx.x);
        EpiSwiglu E{WSP(bf16_t, WS_ACT)};
        pg8::gemm_phase<EpiSwiglu, pg8::StaticOrder, true, true>(lds, g, So, E, wave, lane);
    } }
    SEAM(7);

    { const int rep_ = 0; (void)rep_;
    if (IN(8)) {
        LANE_TID(); (void)tid;
        pg8::Gemm g{WSP(bf16_t, WS_ACT), WSP(bf16_t, WS_WD), S, D, FFH}; pg8::StaticOrder So; So.init(S, D, G, (int)blockIdx.x);
        RowStats st{WSP(unsigned, WS_XBUF + 2 * 262144 + (size_t)rep_ * 786432), WSP(unsigned, WS_CTL) + (rep_ ? 20480 : 1024) + 2 * 4096};
        EpiRmsRes E{WSP(bf16_t, WS_X1), args.out, args.in[12], st};
        pg8::gemm_phase<EpiRmsRes, pg8::StaticOrder, false, true>(lds, g, So, E, wave, lane);
    } }
#undef IN
#undef LANE_TID
#undef WSP
#undef SEAM
}

extern "C" void kernel_launch(void* const* d_in, const int* in_sizes, int n_in, void* d_out, int out_size, void* d_ws, size_t ws_size, hipStream_t stream) {
    static int grid = 0;
    if (grid == 0) {
        if (n_in != 13 || in_sizes[0] != S * D || out_size != S * D || ws_size < WS_END) { fprintf(stderr, "kernel_launch: unexpected shapes (n_in %d, in0 %d, out %d, ws %zu)\n", n_in, n_in > 0 ? in_sizes[0] : -1, out_size, ws_size); grid = -1; return; }
        int dev = 0, cus = 0, per_cu = 0;
        (void)hipGetDevice(&dev);
        (void)hipDeviceGetAttribute(&cus, hipDeviceAttributeMultiprocessorCount, dev);
        if (hipFuncSetAttribute((const void*)fwd_mega, hipFuncAttributeMaxDynamicSharedMemorySize, LDS_BYTES) != hipSuccess) fprintf(stderr, "kernel_launch: hipFuncSetAttribute failed\n");
        if (hipOccupancyMaxActiveBlocksPerMultiprocessor(&per_cu, (const void*)fwd_mega, 512, LDS_BYTES) != hipSuccess || per_cu < 1) { fprintf(stderr, "kernel_launch: occupancy query says %d\n", per_cu); per_cu = 1; }
        (void)hipGetLastError();
        if (cus <= 0) cus = 256;
        grid = cus * per_cu;
    }
    if (grid < 0) return;
    Args a{};
    for (int i = 0; i < 13; ++i) a.in[i] = (const float*)d_in[i];
    a.out = (float*)d_out; a.ws = (unsigned char*)d_ws;
    for (int f = 0; f < 32; ++f) a.invf[f] = (float)pow(10000.0, -(double)f / 32.0);
    a.lo = 0; a.hi = NPHASE;
    (void)hipMemsetAsync((unsigned char*)d_ws + WS_CTL, 0, CTL_ZERO_BYTES, stream);
    void* kargs[] = {&a};
    hipError_t e = hipLaunchCooperativeKernel((const void*)fwd_mega, dim3(grid), dim3(512), kargs, LDS_BYTES, stream);
    if (e != hipSuccess) fprintf(stderr, "kernel_launch: cooperative launch failed: %s (grid %d)\n", hipGetErrorString(e), grid);
}
```

```cpp
#include <hip/hip_runtime.h>
#include <hip/hip_cooperative_groups.h>
#include <cstdio>
#include <cstdint>
#include <cmath>
namespace cg = cooperative_groups;
namespace pg8 {
#define PG8_LAS __attribute__((address_space(3)))
typedef unsigned short bf16_t;
typedef short bf16x8 __attribute__((ext_vector_type(8)));
typedef float f32x4 __attribute__((ext_vector_type(4)));
typedef unsigned u32x4 __attribute__((ext_vector_type(4)));
constexpr int BM = 256, BK = 64, HALF = 128, HTB = HALF * BK * 2  , STAGE_BYTES = 8 * HTB, NXCD = 8, WGM = 8;

__host__ __device__ __forceinline__ int lds_byte(int r, int c) { const int st = (r >> 4) * 2 + (c >> 5), rr = r & 15, cc = c & 31, ob = rr * 64 + cc * 2; return st * 1024 + (ob ^ (((ob >> 9) & 1) << 5)); }
__host__ __device__ __forceinline__ void stage_rc(int b, int& R, int& C) { const int st = b / 1024, sb = b % 1024, swz = sb ^ (((sb >> 9) & 1) << 5); R = (st >> 1) * 16 + swz / 64; C = (st & 1) * 32 + (swz % 64) / 2; }
__host__ __device__ __forceinline__ int perm32(int rho) { const int n = rho >> 4, i = rho & 15; return 8 * (i >> 2) + 4 * n + (i & 3); }

struct Unit { int pm, pn; };
struct Gemm { const bf16_t* A; const bf16_t* Bt; int M, N, K; };

struct StaticOrder {
    int nM, nN, nwg, G, c;
    __host__ __device__ void init(int M, int N, int G_, int c_) { nM = M / BM; nN = N / BM; nwg = nM * nN; G = G_; c = c_; }
    __host__ __device__ bool next(int i, Unit& u) const {
        const long L = (long)i * G + c; if (L >= nwg) return false;
        int wgid = (int)L; { const int q = nwg / NXCD, r = nwg % NXCD, xcd = wgid % NXCD, off = wgid / NXCD; wgid = (xcd < r ? xcd * (q + 1) : r * (q + 1) + (xcd - r) * q) + off; }
        const int nig = WGM * nN, gid = wgid / nig, fm = gid * WGM, gsz = (nM - fm) < WGM ? (nM - fm) : WGM;
        u.pm = fm + ((wgid % nig) % gsz); u.pn = (wgid % nig) / gsz; return true;
    }
    __device__ __forceinline__ void a_ready(const Unit&) const {}
    __device__ __forceinline__ void done(const Unit&) const {}
};
__device__ __forceinline__ unsigned cvt_pk_bf16(float lo, float hi) { unsigned r; asm volatile("v_cvt_pk_bf16_f32 %0, %1, %2" : "=v"(r) : "v"(lo), "v"(hi)); return r; }
typedef float f32x2 __attribute__((ext_vector_type(2)));
template <class Epi, class Sched, bool ALIGN_EPI = false, bool SP2 = false>
__device__ __forceinline__ void gemm_phase(PG8_LAS unsigned char* lds, const Gemm g, const Sched& S, const Epi& E, const int wid, const int lane) {
    const int tid = wid * 64 + lane, wr = wid >> 2, wc = wid & 3, fr = lane & 15, fq = lane >> 4;
    const int K = g.K, nt = K / BK;
    unsigned voffA[2], voffB[2];
#pragma unroll
    for (int i = 0; i < 2; ++i) { int R, C; stage_rc(tid * 16 + i * 8192, R, C); const int Rb = Epi::PERM ? ((R & ~31) + perm32(R & 31)) : R;
        voffA[i] = (unsigned)(R * K + C) * 2u; voffB[i] = (unsigned)(Rb * K + C) * 2u; }
    const size_t kstep = (size_t)(BK * 2);
    const size_t hstep = (size_t)HALF * K * 2;
    const size_t tstep = 2 * hstep;
    const unsigned ldsw = (unsigned)wid * 1024u;
    const int aoff = lds_byte(wr * 64 + fr, fq * 8), boff = lds_byte(wc * 32 + fr, fq * 8);
#define PG8_SA(b, h) (((b) * 2 + (h)) * HTB)
#define PG8_SB(b, h) ((4 + (b) * 2 + (h)) * HTB)
#define PG8_STAGE(bufoff, gbase, voff) do { _Pragma("unroll") for (int _i = 0; _i < 2; ++_i) \
        __builtin_amdgcn_global_load_lds((const unsigned*)((const char*)(gbase) + (voff)[_i]), (PG8_LAS unsigned*)(lds + (bufoff) + ldsw + _i * 8192), 16, 0, 0); } while (0)
#define PG8_LDA(dst, b, h) do { _Pragma("unroll") for (int m = 0; m < 4; ++m) _Pragma("unroll") for (int k = 0; k < 2; ++k) dst[m][k] = *(const PG8_LAS bf16x8*)(lds + PG8_SA(b, h) + aoff + m * 2048 + k * 1024); } while (0)
#define PG8_LDB(dst, b, h) do { _Pragma("unroll") for (int n = 0; n < 2; ++n) _Pragma("unroll") for (int k = 0; k < 2; ++k) dst[n][k] = *(const PG8_LAS bf16x8*)(lds + PG8_SB(b, h) + boff + n * 2048 + k * 1024); } while (0)
#define PG8_MMA(ai, bj, At, Bt) do { __builtin_amdgcn_s_setprio(1); _Pragma("unroll") for (int m = 0; m < 4; ++m) _Pragma("unroll") for (int n = 0; n < 2; ++n) _Pragma("unroll") for (int k = 0; k < 2; ++k) \
        acc[ai][bj][m][n] = __builtin_amdgcn_mfma_f32_16x16x32_bf16(Bt[n][k], At[m][k], acc[ai][bj][m][n], 0, 0, 0); __builtin_amdgcn_s_setprio(0); } while (0)
#define PG8_WAIT_V(n) asm volatile("s_waitcnt vmcnt(" #n ")" ::: "memory")
#define PG8_WAIT_L(n) asm volatile("s_waitcnt lgkmcnt(" #n ")" ::: "memory")
#define PG8_BAR __builtin_amdgcn_s_barrier()
#define PG8_SCHED __builtin_amdgcn_sched_barrier(0)
    Unit cur, nxt; int ui = 0;
    if (!S.next(0, cur)) return;
    f32x4 acc[2][2][4][2];
#pragma unroll
    for (int a = 0; a < 2; ++a)
#pragma unroll
        for (int b = 0; b < 2; ++b)
#pragma unroll
            for (int m = 0; m < 4; ++m)
#pragma unroll
                for (int n = 0; n < 2; ++n) acc[a][b][m][n] = (f32x4){0.f, 0.f, 0.f, 0.f};
    bf16x8 At[4][2], B0[2][2], B1[2][2];
    const char* cA = (const char*)g.A + (size_t)cur.pm * tstep; const char* cB = (const char*)g.Bt + (size_t)cur.pn * tstep;
    S.a_ready(cur);
    if constexpr (SP2) {
        PG8_STAGE(PG8_SB(0, 0), cB, voffB); PG8_STAGE(PG8_SB(0, 1), cB + hstep, voffB); PG8_STAGE(PG8_SA(0, 0), cA, voffA); PG8_STAGE(PG8_SA(0, 1), cA + hstep, voffA);
        if (wr == 1) PG8_BAR;
        PG8_WAIT_V(2); PG8_BAR;
        PG8_STAGE(PG8_SB(1, 0), cB + kstep, voffB); PG8_STAGE(PG8_SA(1, 0), cA + kstep, voffA); PG8_STAGE(PG8_SB(1, 1), cB + hstep + kstep, voffB);
        PG8_WAIT_V(6); PG8_BAR;
    } else {
        PG8_STAGE(PG8_SB(0, 0), cB, voffB); PG8_STAGE(PG8_SA(0, 0), cA, voffA); PG8_STAGE(PG8_SB(0, 1), cB + hstep, voffB); PG8_STAGE(PG8_SA(0, 1), cA + hstep, voffA);
        if (wr == 1) PG8_BAR;
        PG8_WAIT_V(4); PG8_BAR;
        PG8_STAGE(PG8_SB(1, 0), cB + kstep, voffB); PG8_STAGE(PG8_SA(1, 0), cA + kstep, voffA); PG8_STAGE(PG8_SB(1, 1), cB + hstep + kstep, voffB);
        PG8_WAIT_V(6); PG8_BAR;
    }
    for (;;) {
        const bool has_next = S.next(ui + 1, nxt);
        const char* nA = has_next ? (const char*)g.A + (size_t)nxt.pm * tstep : cA; const char* nB = has_next ? (const char*)g.Bt + (size_t)nxt.pn * tstep : cB;
        for (int t = 0; t < nt; t += 2) {
            if constexpr (Epi::HAS_MID) { if (t == (nt >> 1)) E.mid(acc, cur, wr, wc, fr, fq); }
            const bool last = (t == nt - 2);
            const char* a1 = cA + (size_t)(t + 1) * kstep;
            const char* a2 = last ? nA : cA + (size_t)(t + 2) * kstep; const char* b2 = last ? nB : cB + (size_t)(t + 2) * kstep;
            const char* a3 = a2 + kstep; const char* b3 = b2 + kstep;
            if (last && has_next) S.a_ready(nxt);
            if constexpr (SP2) {
            PG8_LDB(B0, 0, 0); PG8_LDB(B1, 0, 1); PG8_SCHED; PG8_LDA(At, 0, 0); PG8_STAGE(PG8_SA(1, 1), a1 + hstep, voffA);
            PG8_WAIT_V(8); PG8_WAIT_L(0); PG8_BAR; PG8_MMA(0, 0, At, B0); PG8_MMA(0, 1, At, B1); PG8_BAR; PG8_SCHED;
            PG8_LDA(At, 0, 1); PG8_STAGE(PG8_SB(0, 0), b2, voffB); PG8_STAGE(PG8_SB(0, 1), b2 + hstep, voffB); PG8_STAGE(PG8_SA(0, 0), a2, voffA);
            PG8_WAIT_V(8); PG8_WAIT_L(0); PG8_BAR; PG8_MMA(1, 0, At, B0); PG8_MMA(1, 1, At, B1); PG8_BAR; PG8_SCHED;
            PG8_LDB(B0, 1, 0); PG8_LDB(B1, 1, 1); PG8_SCHED; PG8_LDA(At, 1, 0); PG8_STAGE(PG8_SA(0, 1), a2 + hstep, voffA);
            PG8_WAIT_V(8); PG8_WAIT_L(0); PG8_BAR; PG8_MMA(0, 0, At, B0); PG8_MMA(0, 1, At, B1); PG8_BAR; PG8_SCHED;
            PG8_LDA(At, 1, 1); PG8_STAGE(PG8_SB(1, 0), b3, voffB); PG8_STAGE(PG8_SB(1, 1), b3 + hstep, voffB); PG8_STAGE(PG8_SA(1, 0), a3, voffA);
            PG8_WAIT_V(8); PG8_WAIT_L(0); PG8_BAR; PG8_MMA(1, 0, At, B0); PG8_MMA(1, 1, At, B1); PG8_BAR; PG8_SCHED;
            } else {
            PG8_LDB(B0, 0, 0); PG8_SCHED; PG8_LDA(At, 0, 0); PG8_STAGE(PG8_SA(1, 1), a1 + hstep, voffA);
            PG8_WAIT_L(8); PG8_BAR; PG8_WAIT_L(0); PG8_MMA(0, 0, At, B0); PG8_BAR; PG8_SCHED;
            PG8_LDB(B1, 0, 1); PG8_STAGE(PG8_SB(0, 0), b2, voffB);
            PG8_BAR; PG8_WAIT_L(0); PG8_MMA(0, 1, At, B1); PG8_BAR;
            PG8_LDA(At, 0, 1); PG8_STAGE(PG8_SA(0, 0), a2, voffA);
            PG8_BAR; PG8_WAIT_L(0); PG8_MMA(1, 0, At, B0); PG8_BAR; PG8_SCHED;
            PG8_STAGE(PG8_SB(0, 1), b2 + hstep, voffB);
            PG8_WAIT_V(6); PG8_BAR; PG8_MMA(1, 1, At, B1); PG8_BAR;
            PG8_LDB(B0, 1, 0); PG8_SCHED; PG8_LDA(At, 1, 0); PG8_STAGE(PG8_SA(0, 1), a2 + hstep, voffA);
            PG8_WAIT_L(8); PG8_BAR; PG8_WAIT_L(0); PG8_MMA(0, 0, At, B0); PG8_BAR; PG8_SCHED;
            PG8_LDB(B1, 1, 1); PG8_STAGE(PG8_SB(1, 0), b3, voffB);
            PG8_BAR; PG8_WAIT_L(0); PG8_MMA(0, 1, At, B1); PG8_BAR;
            PG8_LDA(At, 1, 1); PG8_STAGE(PG8_SA(1, 0), a3, voffA);
            PG8_BAR; PG8_WAIT_L(0); PG8_MMA(1, 0, At, B0); PG8_BAR; PG8_SCHED;
            PG8_STAGE(PG8_SB(1, 1), b3 + hstep, voffB);
            PG8_WAIT_V(6); PG8_BAR; PG8_MMA(1, 1, At, B1); PG8_BAR;
            }
        }
        if constexpr (ALIGN_EPI) { if (wr == 0) PG8_BAR; }
        if constexpr (!Epi::AFTER_DRAIN) { E(acc, cur, wr, wc, fr, fq); S.done(cur); }
        if (!has_next) break;
#pragma unroll
        for (int a = 0; a < 2; ++a)
#pragma unroll
            for (int b = 0; b < 2; ++b)
#pragma unroll
                for (int m = 0; m < 4; ++m)
#pragma unroll
                    for (int n = 0; n < 2; ++n) acc[a][b][m][n] = (f32x4){0.f, 0.f, 0.f, 0.f};
        cur = nxt; cA = nA; cB = nB; ++ui;
        if constexpr (ALIGN_EPI) { if (wr == 1) PG8_BAR; }
    }
    PG8_WAIT_V(0);
    if constexpr (!ALIGN_EPI) { if (wr == 0) PG8_BAR; }
    PG8_BAR;
    if constexpr (Epi::AFTER_DRAIN) { E.fused(acc, cur, wr, wc, fr, fq, lds, wid, lane); S.done(cur); }
#undef PG8_SA
#undef PG8_SB
#undef PG8_STAGE
#undef PG8_LDA
#undef PG8_LDB
#undef PG8_MMA
#undef PG8_WAIT_V
#undef PG8_WAIT_L
#undef PG8_BAR
#undef PG8_SCHED
}
}
#ifndef REP_PHASE
#define REP_PHASE -1
#endif
#define NREP(k) ((k) == REP_PHASE ? 2 : 1)

constexpr int S = 16384, D = 1024, NIN = 4608, FFH = 2816, NGU = 2 * FFH;
constexpr int NHEAD = 12, HD = 64;
constexpr float EPS = 1e-6f;
constexpr int LDS_BYTES = 147456;
constexpr int NPHASE = 10;

#define LAS __attribute__((address_space(3)))
typedef unsigned short bf16_t;
typedef short bf16x8 __attribute__((ext_vector_type(8)));
typedef float f32x4 __attribute__((ext_vector_type(4)));
typedef unsigned u32x4 __attribute__((ext_vector_type(4)));
typedef unsigned u32x2 __attribute__((ext_vector_type(2)));

constexpr size_t MiB = 1u << 20;
constexpr size_t WS_WIN = 0;
constexpr size_t WS_WPA = 9 * MiB;
constexpr size_t WS_WOUT = 10 * MiB;
constexpr size_t WS_WGU = 12 * MiB;
constexpr size_t WS_WD = 23 * MiB;
constexpr size_t WS_WMT = 29 * MiB;
constexpr size_t WS_TAB = 30 * MiB;
constexpr size_t WS_H = 34 * MiB;
constexpr size_t WS_QKV = 66 * MiB;
constexpr size_t WS_U = 138 * MiB;
constexpr size_t WS_GATES = 146 * MiB;
constexpr size_t WS_OG = 210 * MiB;
constexpr size_t WS_LSE = 234 * MiB;
constexpr size_t WS_OA = 235 * MiB;
constexpr size_t WS_H2 = 154 * MiB;
constexpr size_t WS_X1 = 186 * MiB;
constexpr size_t WS_ACT = 66 * MiB;
constexpr size_t WS_CTL = 251 * MiB;
constexpr size_t CTL_ZERO_BYTES = 131072;
constexpr int CW_XBAR = 16384;
constexpr size_t WS_XBUF = 251 * MiB + 131072;
constexpr size_t WS_END = (REP_PHASE >= 0 ? 253 : 252) * MiB;

__device__ __forceinline__ float bf2f(unsigned bits16) { return __builtin_bit_cast(float, bits16 << 16); }
typedef float f32x2_t __attribute__((ext_vector_type(2)));
typedef __bf16 bf16x2_t __attribute__((ext_vector_type(2)));
__device__ __forceinline__ unsigned pk2(float lo, float hi) { f32x2_t v = {lo, hi}; bf16x2_t b = __builtin_convertvector(v, bf16x2_t); return __builtin_bit_cast(unsigned, b); }
__device__ __forceinline__ float wave_sum(float v) {
#pragma unroll
    for (int o = 1; o < 64; o <<= 1) v += __shfl_xor(v, o);
    return v;
}
__device__ __forceinline__ int lane_id_asm() { int l; asm volatile("v_mbcnt_lo_u32_b32 %0, -1, 0\n\tv_mbcnt_hi_u32_b32 %0, -1, %0" : "=v"(l)); return l; }
__device__ __forceinline__ float sigmoidf_(float v) { return __builtin_amdgcn_rcpf(1.0f + __builtin_amdgcn_exp2f(v * -1.4426950408889634f)); }

__host__ __device__ __forceinline__ int in_tile(int pn) { return pn < 8 ? pn + 10 : (pn < 14 ? pn - 8 : (pn == 14 ? 9 : pn - 9)); }
#define OPQ(p) asm volatile("" : "+v"(p))
#define EPI_ROWS_BEGIN _Pragma("unroll") for (int ai = 0; ai < 2; ++ai) { _Pragma("unroll") for (int m = 0; m < 4; ++m) {
#define EPI_ROWS_END(step16, step64) } }
struct EpiIn {
    static constexpr bool PERM = true, AFTER_DRAIN = false, HAS_MID = false;
    bf16_t* qkv; bf16_t* ub; bf16_t* gates; const float* tab;
    __device__ __forceinline__ void operator()(const f32x4 (&acc)[2][2][4][2], const pg8::Unit& u, int wr, int wc, int fr, int fq) const {
        const int pn = in_tile(u.pn);
        const int r0 = u.pm * 256 + wr * 64 + fr;
        if (pn < 6) {
            const int T = pn / 3, g3 = pn - 3 * T, sh = 2 * g3;
            const int rowp0 = ((r0 & ((1 << sh) - 1)) << (14 - sh)) + (r0 >> sh);
            bf16_t* dst = qkv + (((size_t)T * NHEAD + g3 * 4 + wc) * S + rowp0) * HD + 8 * fq;
            const float* tp = tab + ((size_t)r0 * 32 + 8 * fq) * 2;
            const int dstep = (16 >> sh) * HD;
#pragma unroll
            for (int ai = 0; ai < 2; ++ai) {
#pragma unroll
                for (int m = 0; m < 4; ++m) {
                    u32x4 w1, w2;
#pragma unroll
                    for (int n = 0; n < 2; ++n) {
                        const f32x4 cs0 = *(const f32x4*)(tp + 8 * n), cs1 = *(const f32x4*)(tp + 8 * n + 4);
                        const f32x4 a = acc[ai][0][m][n], b = acc[ai][1][m][n];
                        const float o10 = a[0] * cs0[0] - b[0] * cs0[1], o20 = b[0] * cs0[0] + a[0] * cs0[1];
                        const float o11 = a[1] * cs0[2] - b[1] * cs0[3], o21 = b[1] * cs0[2] + a[1] * cs0[3];
                        const float o12 = a[2] * cs1[0] - b[2] * cs1[1], o22 = b[2] * cs1[0] + a[2] * cs1[1];
                        const float o13 = a[3] * cs1[2] - b[3] * cs1[3], o23 = b[3] * cs1[2] + a[3] * cs1[3];
                        w1[2 * n] = pk2(o10, o11); w1[2 * n + 1] = pk2(o12, o13); w2[2 * n] = pk2(o20, o21); w2[2 * n + 1] = pk2(o22, o23);
                    }
                    *(u32x4*)dst = w1; *(u32x4*)(dst + 32) = w2;
                    dst += dstep; tp += 16 * 64; OPQ(dst); OPQ(tp);
                }
                dst += 4 * dstep; tp += 64 * 64; OPQ(dst); OPQ(tp);
            }
        } else if (pn < 9) {
            const int g3 = pn - 6, sh = 2 * g3;
            const int rowp0 = ((r0 & ((1 << sh) - 1)) << (14 - sh)) + (r0 >> sh);
            bf16_t* dst = qkv + (((size_t)2 * NHEAD + g3 * 4 + (wc >> 1)) * S + rowp0) * HD + 32 * (wc & 1) + 8 * fq;
            const int dstep = (16 >> sh) * HD;
#pragma unroll
            for (int ai = 0; ai < 2; ++ai) {
#pragma unroll
                for (int m = 0; m < 4; ++m) {
#pragma unroll
                    for (int bj = 0; bj < 2; ++bj) { const f32x4 a0 = acc[ai][bj][m][0], a1 = acc[ai][bj][m][1];
                        u32x4 wv; wv.x = pk2(a0[0], a0[1]); wv.y = pk2(a0[2], a0[3]); wv.z = pk2(a1[0], a1[1]); wv.w = pk2(a1[2], a1[3]); *(u32x4*)(dst + (size_t)bj * 2 * S * HD) = wv; }
                    dst += dstep; OPQ(dst);
                }
                dst += 4 * dstep; OPQ(dst);
            }
        } else if (pn == 9) {
            bf16_t* dst = ub + (size_t)r0 * 256 + 32 * wc + 8 * fq;
#pragma unroll
            for (int ai = 0; ai < 2; ++ai) {
#pragma unroll
                for (int m = 0; m < 4; ++m) {
#pragma unroll
                    for (int bj = 0; bj < 2; ++bj) { const f32x4 a0 = acc[ai][bj][m][0], a1 = acc[ai][bj][m][1];
                        u32x4 wv; wv.x = pk2(a0[0], a0[1]); wv.y = pk2(a0[2], a0[3]); wv.z = pk2(a1[0], a1[1]); wv.w = pk2(a1[2], a1[3]); *(u32x4*)(dst + 128 * bj) = wv; }
                    dst += 16 * 256; OPQ(dst);
                }
                dst += 64 * 256; OPQ(dst);
            }
        } else {
            const int tg = pn - 10, wid = wr * 4 + wc, lane = fq * 16 + fr;
            unsigned char* dst = (unsigned char*)gates + ((size_t)(u.pm * 8 + tg) * 2) * 65536 + (wid * 64 + lane) * 16;
#pragma unroll
            for (int ai = 0; ai < 2; ++ai)
#pragma unroll
                for (int m = 0; m < 4; ++m) {
                    u32x4 w0, w1;
#pragma unroll
                    for (int n = 0; n < 2; ++n) {
                        const f32x4 a = acc[ai][0][m][n], b = acc[ai][1][m][n];
                        f32x4 ra, sp;
#pragma unroll
                        for (int j = 0; j < 4; ++j) { const float pa = 1.0f + __builtin_amdgcn_exp2f(fminf(a[j] * -1.4426950408889634f, 60.0f)), pb = 1.0f + __builtin_amdgcn_exp2f(fminf(b[j] * -1.4426950408889634f, 60.0f));
                            const float rr = __builtin_amdgcn_rcpf(pa * pb);
                            sp[j] = pa * rr; ra[j] = pb * pb * rr; }
                        w0[2 * n] = pk2(ra[0], ra[1]); w0[2 * n + 1] = pk2(ra[2], ra[3]); w1[2 * n] = pk2(sp[0], sp[1]); w1[2 * n + 1] = pk2(sp[2], sp[3]);
                    }
                    *(u32x4*)dst = w0; *(u32x4*)(dst + 65536) = w1;
                    dst += 8192; OPQ(dst);
                }
        }
    }
};

struct EpiGate2 {
    static constexpr bool PERM = true, AFTER_DRAIN = false, HAS_MID = true;
    const bf16_t* gates; bf16_t* merged;
    __device__ __forceinline__ void mid(f32x4 (&acc)[2][2][4][2], const pg8::Unit& u, int wr, int wc, int fr, int fq) const {
        const int wid = wr * 4 + wc, lane = fq * 16 + fr;
#pragma unroll
        for (int bj = 0; bj < 2; ++bj) {
            const unsigned char* gp = (const unsigned char*)gates + ((size_t)(u.pm * 8 + 2 * u.pn + bj) * 2) * 65536 + (wid * 64 + lane) * 16;
#pragma unroll
            for (int ai = 0; ai < 2; ++ai)
#pragma unroll
                for (int m = 0; m < 4; ++m) {
                    const u32x4 ga = __builtin_nontemporal_load((const u32x4*)gp);
#pragma unroll
                    for (int n = 0; n < 2; ++n) { f32x4 ra; ra[0] = bf2f(ga[2 * n] & 0xffffu); ra[1] = bf2f(ga[2 * n] >> 16); ra[2] = bf2f(ga[2 * n + 1] & 0xffffu); ra[3] = bf2f(ga[2 * n + 1] >> 16);
                        acc[ai][bj][m][n] = acc[ai][bj][m][n] * ra; }
                    gp += 8192; OPQ(gp);
                }
        }
    }
    __device__ __forceinline__ void operator()(const f32x4 (&acc)[2][2][4][2], const pg8::Unit& u, int wr, int wc, int fr, int fq) const {
        const int wid = wr * 4 + wc, lane = fq * 16 + fr;
        const int r0 = u.pm * 256 + wr * 64 + fr, c0 = u.pn * 256 + 32 * wc + 8 * fq;
#pragma unroll
        for (int bj = 0; bj < 2; ++bj) {
            const unsigned char* gp = (const unsigned char*)gates + ((size_t)(u.pm * 8 + 2 * u.pn + bj) * 2 + 1) * 65536 + (wid * 64 + lane) * 16;
            bf16_t* mp = merged + (size_t)r0 * D + c0 + 128 * bj;
#pragma unroll
            for (int ai = 0; ai < 2; ++ai) {
#pragma unroll
                for (int m = 0; m < 4; ++m) {
                    const u32x4 gw = __builtin_nontemporal_load((const u32x4*)gp);
                    u32x4 wv;
#pragma unroll
                    for (int n = 0; n < 2; ++n) { f32x4 g; g[0] = bf2f(gw[2 * n] & 0xffffu); g[1] = bf2f(gw[2 * n] >> 16); g[2] = bf2f(gw[2 * n + 1] & 0xffffu); g[3] = bf2f(gw[2 * n + 1] >> 16);
                        const f32x4 o = acc[ai][bj][m][n] * g; wv[2 * n] = pk2(o[0], o[1]); wv[2 * n + 1] = pk2(o[2], o[3]); }
                    *(u32x4*)mp = wv;
                    gp += 8192; OPQ(gp);
                    mp += 16 * D; OPQ(mp);
                }
                mp += 64 * D; OPQ(mp);
            }
        }
    }
};

struct EpiF32 {
    static constexpr bool PERM = false, AFTER_DRAIN = false, HAS_MID = false;
    float* out; int ldc;
    __device__ __forceinline__ void operator()(const f32x4 (&acc)[2][2][4][2], const pg8::Unit& u, int wr, int wc, int fr, int fq) const {
        float* op = out + (size_t)(u.pm * 256 + wr * 64 + fr) * ldc + u.pn * 256 + 32 * wc + 4 * fq;
#pragma unroll
        for (int ai = 0; ai < 2; ++ai) {
#pragma unroll
            for (int m = 0; m < 4; ++m) {
#pragma unroll
                for (int bj = 0; bj < 2; ++bj)
#pragma unroll
                    for (int n = 0; n < 2; ++n) *(f32x4*)(op + 128 * bj + 16 * n) = acc[ai][bj][m][n];
                op += 16 * (size_t)ldc; OPQ(op);
            }
            op += 64 * (size_t)ldc; OPQ(op);
        }
    }
};

struct EpiSwiglu {
    static constexpr bool PERM = true, AFTER_DRAIN = false, HAS_MID = false;
    bf16_t* act;
    __device__ __forceinline__ void operator()(const f32x4 (&acc)[2][2][4][2], const pg8::Unit& u, int wr, int wc, int fr, int fq) const {
        bf16_t* op = act + (size_t)(u.pm * 256 + wr * 64 + fr) * FFH + u.pn * 128 + 32 * wc + 8 * fq;
#pragma unroll
        for (int ai = 0; ai < 2; ++ai) {
#pragma unroll
            for (int m = 0; m < 4; ++m) {
                u32x4 wv;
#pragma unroll
                for (int n = 0; n < 2; ++n) {
                    const f32x4 a = acc[ai][0][m][n], b = acc[ai][1][m][n];
                    f32x4 o;
#pragma unroll
                    for (int j = 0; j < 4; ++j) o[j] = a[j] * sigmoidf_(a[j]) * b[j];
                    wv[2 * n] = pk2(o[0], o[1]); wv[2 * n + 1] = pk2(o[2], o[3]);
                }
                __builtin_nontemporal_store(wv, (u32x4*)op);
                op += 16 * FFH; OPQ(op);
            }
            op += 64 * FFH; OPQ(op);
        }
    }
};

struct RowStats {
    unsigned* xbuf;
    unsigned* cnt;
    __device__ __forceinline__ void run(const f32x4 (&v)[2][2][4][2], const pg8::Unit& u, int wr, int wc, int fr, int fq, LAS unsigned char* lds, int wid, int lane) const {
        LAS float* P = (LAS float*)lds;
        LAS float* Sg = (LAS float*)(lds + 8192);
#pragma unroll
        for (int ai = 0; ai < 2; ++ai)
#pragma unroll
            for (int m = 0; m < 4; ++m) {
                float q = 0.f;
#pragma unroll
                for (int bj = 0; bj < 2; ++bj)
#pragma unroll
                    for (int n = 0; n < 2; ++n) { const f32x4 d = v[ai][bj][m][n]; q += (d[0] * d[0] + d[1] * d[1]) + (d[2] * d[2] + d[3] * d[3]); }
                q += __shfl_xor(q, 16); q += __shfl_xor(q, 32);
                if (fq == 0) P[(ai * 128 + wr * 64 + m * 16 + fr) * 4 + wc] = q;
            }
        asm volatile("s_waitcnt lgkmcnt(0)" ::: "memory"); __builtin_amdgcn_s_barrier(); asm volatile("" ::: "memory");
        const int row = wid * 32 + (lane & 31);
        if (lane < 32) {
            const float tot = (P[row * 4 + 0] + P[row * 4 + 1]) + (P[row * 4 + 2] + P[row * 4 + 3]);
            __hip_atomic_store(xbuf + ((size_t)(u.pm * 256 + row) * 4 + u.pn), __builtin_bit_cast(unsigned, tot), __ATOMIC_RELAXED, __HIP_MEMORY_SCOPE_AGENT);
        }
        asm volatile("s_waitcnt vmcnt(0)" ::: "memory");
        if (lane == 0) __hip_atomic_fetch_add(cnt + 64 * u.pm, 1u, __ATOMIC_RELAXED, __HIP_MEMORY_SCOPE_AGENT);
        if (wid == 0) {
            unsigned spins = 0;
            while ((unsigned)__builtin_amdgcn_readfirstlane(__hip_atomic_load(cnt + 64 * u.pm, __ATOMIC_RELAXED, __HIP_MEMORY_SCOPE_AGENT)) < 32u) {
                __builtin_amdgcn_s_sleep(2); if (++spins > (1u << 22)) break; }
            __builtin_amdgcn_fence(__ATOMIC_ACQUIRE, "agent");
        }
        asm volatile("s_waitcnt vmcnt(0) lgkmcnt(0)" ::: "memory"); __builtin_amdgcn_s_barrier(); asm volatile("" ::: "memory");
        if (lane < 32) {
            const unsigned* slot = xbuf + (size_t)(u.pm * 256 + row) * 4; float t[4];
#pragma unroll
            for (int k = 0; k < 4; ++k) t[k] = __builtin_bit_cast(float, __hip_atomic_load(slot + k, __ATOMIC_RELAXED, __HIP_MEMORY_SCOPE_AGENT));
            Sg[row] = 1.0f / sqrtf(((t[0] + t[1]) + (t[2] + t[3])) * (1.0f / D) + EPS);
        }
        asm volatile("s_waitcnt lgkmcnt(0)" ::: "memory"); __builtin_amdgcn_s_barrier(); asm volatile("" ::: "memory");
    }
};
struct EpiRmsResRms {
    static constexpr bool PERM = true, AFTER_DRAIN = true, HAS_MID = false;
    const float* base; bf16_t* x1b; bf16_t* xn; const float* g1; const float* g2; RowStats st1, st2;
    __device__ __forceinline__ void fused(f32x4 (&acc)[2][2][4][2], const pg8::Unit& u, int wr, int wc, int fr, int fq, LAS unsigned char* lds, int wid, int lane) const {
        const LAS float* Sg = (const LAS float*)(lds + 8192);
        const int col0 = u.pn * 256 + wc * 32 + 8 * fq;
        const float* bp = base + (size_t)(u.pm * 256 + wr * 64 + fr) * D + col0;
        f32x4 pre[4][2][2];
#pragma unroll
        for (int m = 0; m < 4; ++m)
#pragma unroll
            for (int bj = 0; bj < 2; ++bj)
#pragma unroll
                for (int n = 0; n < 2; ++n) pre[m][bj][n] = __builtin_nontemporal_load((const f32x4*)(bp + (size_t)m * 16 * D + bj * 128 + n * 4));
        st1.run(acc, u, wr, wc, fr, fq, lds, wid, lane);
        {
            f32x4 gv[2][2];
#pragma unroll
            for (int bj = 0; bj < 2; ++bj)
#pragma unroll
                for (int n = 0; n < 2; ++n) gv[bj][n] = *(const f32x4*)(g1 + col0 + bj * 128 + n * 4);
#pragma unroll
            for (int ai = 0; ai < 2; ++ai) {
#pragma unroll
                for (int m = 0; m < 4; ++m) {
                    const float r1 = Sg[ai * 128 + wr * 64 + m * 16 + fr];
#pragma unroll
                    for (int bj = 0; bj < 2; ++bj)
#pragma unroll
                        for (int n = 0; n < 2; ++n) { const f32x4 bs = pre[m][bj][n]; acc[ai][bj][m][n] = bs + acc[ai][bj][m][n] * r1 * gv[bj][n]; }
                    if (ai == 0) {
#pragma unroll
                        for (int bj = 0; bj < 2; ++bj)
#pragma unroll
                            for (int n = 0; n < 2; ++n) pre[m][bj][n] = __builtin_nontemporal_load((const f32x4*)(bp + (size_t)128 * D + bj * 128 + n * 4));
                    }
                    asm volatile("" : "+v"(acc[ai][0][m][0]), "+v"(acc[ai][0][m][1]), "+v"(acc[ai][1][m][0]), "+v"(acc[ai][1][m][1]));
                    bp += 16 * D; OPQ(bp);
                    if (m & 1) asm volatile("" ::: "memory");
                }
                bp += 64 * D; OPQ(bp);
            }
        }
        st2.run(acc, u, wr, wc, fr, fq, lds, wid, lane);
        {
            f32x4 gv[2][2];
#pragma unroll
            for (int bj = 0; bj < 2; ++bj)
#pragma unroll
                for (int n = 0; n < 2; ++n) gv[bj][n] = *(const f32x4*)(g2 + col0 + bj * 128 + n * 4);
            bf16_t* op = x1b + (size_t)(u.pm * 256 + wr * 64 + fr) * D + col0; bf16_t* xp = xn + (size_t)(u.pm * 256 + wr * 64 + fr) * D + col0;
#pragma unroll
            for (int ai = 0; ai < 2; ++ai) {
#pragma unroll
                for (int m = 0; m < 4; ++m) {
                    const float r2 = Sg[ai * 128 + wr * 64 + m * 16 + fr];
#pragma unroll
                    for (int bj = 0; bj < 2; ++bj) { u32x4 wx, wv;
#pragma unroll
                        for (int n = 0; n < 2; ++n) { const f32x4 x1 = acc[ai][bj][m][n]; wx[2 * n] = pk2(x1[0], x1[1]); wx[2 * n + 1] = pk2(x1[2], x1[3]);
                            const f32x4 o = x1 * r2 * gv[bj][n]; wv[2 * n] = pk2(o[0], o[1]); wv[2 * n + 1] = pk2(o[2], o[3]); }
                        *(u32x4*)(op + bj * 128) = wx; *(u32x4*)(xp + bj * 128) = wv; }
                    op += 16 * D; xp += 16 * D; OPQ(op); OPQ(xp);
                }
                op += 64 * D; xp += 64 * D; OPQ(op); OPQ(xp);
            }
        }
    }
};
struct EpiRmsRes {
    static constexpr bool PERM = true, AFTER_DRAIN = true, HAS_MID = false;
    const bf16_t* x1b; float* out; const float* g1; RowStats st;
    __device__ __forceinline__ void fused(f32x4 (&acc)[2][2][4][2], const pg8::Unit& u, int wr, int wc, int fr, int fq, LAS unsigned char* lds, int wid, int lane) const {
        const LAS float* Sg = (const LAS float*)(lds + 8192);
        const int col0 = u.pn * 256 + wc * 32 + 8 * fq;
        const bf16_t* bp = x1b + (size_t)(u.pm * 256 + wr * 64 + fr) * D + col0; float* op = out + (size_t)(u.pm * 256 + wr * 64 + fr) * D + col0;
        u32x4 pre[2][4][2];
#pragma unroll
        for (int ai = 0; ai < 2; ++ai)
#pragma unroll
            for (int m = 0; m < 4; ++m)
#pragma unroll
                for (int bj = 0; bj < 2; ++bj) pre[ai][m][bj] = __builtin_nontemporal_load((const u32x4*)(bp + (size_t)(ai * 128 + m * 16) * D + bj * 128));
        st.run(acc, u, wr, wc, fr, fq, lds, wid, lane);
        f32x4 gv[2][2];
#pragma unroll
        for (int bj = 0; bj < 2; ++bj)
#pragma unroll
            for (int n = 0; n < 2; ++n) gv[bj][n] = *(const f32x4*)(g1 + col0 + bj * 128 + n * 4);
#pragma unroll
        for (int ai = 0; ai < 2; ++ai) {
#pragma unroll
            for (int m = 0; m < 4; ++m) {
                const float r1 = Sg[ai * 128 + wr * 64 + m * 16 + fr];
#pragma unroll
                for (int bj = 0; bj < 2; ++bj)
#pragma unroll
                    for (int n = 0; n < 2; ++n) { const unsigned px = pre[ai][m][bj][2 * n], py = pre[ai][m][bj][2 * n + 1]; f32x4 bs; bs[0] = bf2f(px & 0xffffu); bs[1] = bf2f(px >> 16); bs[2] = bf2f(py & 0xffffu); bs[3] = bf2f(py >> 16);
                        *(f32x4*)(op + bj * 128 + n * 4) = bs + acc[ai][bj][m][n] * r1 * gv[bj][n]; }
                op += 16 * D; OPQ(op);
            }
            op += 64 * D; OPQ(op);
        }
    }
};

template <int MAP> __device__ __forceinline__ int src_col(int s) {
    if (MAP == 1) s = in_tile(s >> 8) * 256 + (s & 255);
    if (MAP == 1) { if (s < 1536) { const int bj = (s >> 7) & 1, wc = (s >> 5) & 3, rest = s & 31; return (s & ~255) + 64 * wc + 32 * bj + rest; }
                    if (s >= 2560) { const int tg = (s - 2560) >> 8, bj = (s >> 7) & 1, cc = s & 127; return 2560 + bj * 1024 + 128 * tg + cc; } return s; }
    if (MAP == 2) { const int pn = s >> 8, bj = (s >> 7) & 1, cc = s & 127; return bj * FFH + 128 * pn + cc; }
    return s;
}
template <int MAP> __device__ __forceinline__ void transpose_item(const float* W, int K, int N, bf16_t* WT, LAS float* scr, int item, int lane, int ldk = 0) {
    const int nblk = N / 32, kb = item / nblk, nb = item % nblk, k0 = 64 * kb, n0 = 32 * nb;
    const int sc = src_col<MAP>(n0 + (lane & 31));
    float tv[32];
#pragma unroll
    for (int i = 0; i < 32; ++i) tv[i] = __builtin_nontemporal_load(W + (size_t)(k0 + 2 * i + (lane >> 5)) * N + sc);
#pragma unroll
    for (int i = 0; i < 32; ++i) scr[(2 * i + (lane >> 5)) * 33 + (lane & 31)] = tv[i];
    asm volatile("s_waitcnt lgkmcnt(0)" ::: "memory");
    const int c = lane & 7;
#pragma unroll
    for (int j = 0; j < 4; ++j) { const int n = (lane >> 3) + 8 * j; const LAS float* s = scr + (8 * c) * 33 + n;
        u32x4 o; o.x = pk2(s[0 * 33], s[1 * 33]); o.y = pk2(s[2 * 33], s[3 * 33]); o.z = pk2(s[4 * 33], s[5 * 33]); o.w = pk2(s[6 * 33], s[7 * 33]);
        *(u32x4*)(WT + (size_t)(n0 + n) * (ldk ? ldk : K) + k0 + 8 * c) = o; }
    asm volatile("s_waitcnt lgkmcnt(0)" ::: "memory");
}

template <int MAP> __device__ __forceinline__ void transpose_sub(const float* W, int K, int N, bf16_t* WT, LAS float* scr, int item, int sub, int lane) {
    const int nblk = N / 32, kb = item / nblk, nb = item % nblk, k0 = 64 * kb + 8 * sub, n0 = 32 * nb;
    const int sc = src_col<MAP>(n0 + (lane & 31));
    float tv[4];
#pragma unroll
    for (int i = 0; i < 4; ++i) tv[i] = __builtin_nontemporal_load(W + (size_t)(k0 + 2 * i + (lane >> 5)) * N + sc);
#pragma unroll
    for (int i = 0; i < 4; ++i) scr[(2 * i + (lane >> 5)) * 33 + (lane & 31)] = tv[i];
    asm volatile("s_waitcnt lgkmcnt(0)" ::: "memory");
    if (lane < 32) { const LAS float* sp = scr + lane;
        u32x4 o; o.x = pk2(sp[0 * 33], sp[1 * 33]); o.y = pk2(sp[2 * 33], sp[3 * 33]); o.z = pk2(sp[4 * 33], sp[5 * 33]); o.w = pk2(sp[6 * 33], sp[7 * 33]);
        *(u32x4*)(WT + (size_t)(n0 + lane) * K + k0) = o; }
    asm volatile("s_waitcnt lgkmcnt(0)" ::: "memory");
}

template <int W> __device__ __forceinline__ void pool_unit(const bf16_t* Ub, const bf16_t* WmT, const float* pool_scale, bf16_t* YP, int tt, int g, int c, int q) {
    const int t = 16 * tt + c;
    const int cnt = (t + 1 < W) ? t + 1 : W; const float rc = 1.0f / (float)cnt;
    bf16x8 zf[2];
#pragma unroll
    for (int kc = 0; kc < 2; ++kc) {
        const bf16_t* up = Ub + (size_t)t * 256 + g * 64 + 32 * kc + 8 * q;
        u32x4 v[W];
#pragma unroll
        for (int i = 0; i < W; ++i) { const int ti = (i <= t) ? i : 0; v[i] = *(const u32x4*)(up - (size_t)ti * 256); }
        float sum[8];
#pragma unroll
        for (int e = 0; e < 8; ++e) sum[e] = 0.f;
#pragma unroll
        for (int i = 0; i < W; ++i) { const float wgt = (i <= t) ? 1.0f : 0.0f;
#pragma unroll
            for (int e = 0; e < 4; ++e) { sum[2 * e] += wgt * bf2f(v[i][e] & 0xffffu); sum[2 * e + 1] += wgt * bf2f(v[i][e] >> 16); } }
        u32x4 zw;
#pragma unroll
        for (int e = 0; e < 4; ++e) zw[e] = pk2(sum[2 * e] * rc - bf2f(v[0][e] & 0xffffu), sum[2 * e + 1] * rc - bf2f(v[0][e] >> 16));
        zf[kc] = __builtin_bit_cast(bf16x8, zw);
    }
#pragma unroll
    for (int dt = 0; dt < 4; ++dt) {
        const bf16_t* wp = WmT + (size_t)g * 4096 + (16 * dt + c) * 64 + 8 * q;
        const bf16x8 a0 = *(const bf16x8*)wp, a1 = *(const bf16x8*)(wp + 32);
        f32x4 a = (f32x4){0.f, 0.f, 0.f, 0.f};
        a = __builtin_amdgcn_mfma_f32_16x16x32_bf16(a0, zf[0], a, 0, 0, 0);
        a = __builtin_amdgcn_mfma_f32_16x16x32_bf16(a1, zf[1], a, 0, 0, 0);
        const f32x4 scl = *(const f32x4*)(pool_scale + g * 64 + 16 * dt + 4 * q);
        u32x2 wv; wv.x = pk2(a[0] * scl[0], a[1] * scl[1]); wv.y = pk2(a[2] * scl[2], a[3] * scl[3]);
        *(u32x2*)(YP + (size_t)t * 512 + 256 + g * 64 + 16 * dt + 4 * q) = wv;
    }
}

#define XB_TMO      128
#define XB_XCNT(j)  (256  + 64 * (j))
#define XB_XSUB(j)  (1280 + 64 * (j))
#define XB_XGEN(j)  (2304 + 64 * (j))
#define XB_TOP      3328
#define XB_TOPGEN   3392
#define XCD_BAR_WORDS 3456
#define XB_SPIN_CAP (1u << 18)

__device__ __forceinline__ unsigned xb_ld(unsigned* p)              { return __hip_atomic_load(p, __ATOMIC_RELAXED, __HIP_MEMORY_SCOPE_AGENT); }
__device__ __forceinline__ unsigned xb_add(unsigned* p, unsigned v) { return __hip_atomic_fetch_add(p, v, __ATOMIC_RELAXED, __HIP_MEMORY_SCOPE_AGENT); }
__device__ __forceinline__ unsigned xb_xcc_id() { return (unsigned)__builtin_amdgcn_s_getreg((3 << 11) | 20) & 0xFu; }
#define XB_SPIN(cond, bar) do { unsigned _sp = 0; while (cond) { __builtin_amdgcn_s_sleep(1); \
    if ((++_sp & 255u) == 0u) { if (xb_ld(&(bar)[XB_TMO])) break; if (_sp > XB_SPIN_CAP) { atomicAdd(&(bar)[XB_TMO], 1u); break; } } } } while (0)

struct XcdBarrier {
    unsigned* bar; unsigned x;
    volatile LAS unsigned* st;
};

__device__ __forceinline__ XcdBarrier xcd_barrier_post(unsigned* bar, volatile LAS unsigned* st) {
    XcdBarrier b; b.bar = bar; b.x = xb_xcc_id(); b.st = st;
    if (threadIdx.x == 0) (void)xb_add(&bar[XB_XCNT(b.x)], 1u);
    return b;
}
__device__ __forceinline__ void xcd_barrier_complete(unsigned* bar, unsigned x, unsigned& nloc, unsigned& nx) {
    const unsigned G = gridDim.x * gridDim.y * gridDim.z;
    unsigned sum, cnt, mine, sp = 0u;
    for (;;) {
        sum = 0u; cnt = 0u; mine = 0u;
#pragma unroll
        for (unsigned j = 0; j < 16; ++j) { const unsigned c = xb_ld(&bar[XB_XCNT(j)]); sum += c; cnt += (c > 0u) ? 1u : 0u; mine = (j == x) ? c : mine; }
        if (sum == G) break;
        __builtin_amdgcn_s_sleep(1);
        if ((++sp & 255u) == 0u) { if (xb_ld(&bar[XB_TMO])) break; if (sp > XB_SPIN_CAP) { atomicAdd(&bar[XB_TMO], 1u); break; } }
    }
    nloc = mine > 0u ? mine : 1u; nx = cnt > 0u ? cnt : 1u;
}

__device__ __forceinline__ void xcd_barrier(const XcdBarrier& b) {
    asm volatile("s_waitcnt vmcnt(0)" ::: "memory");
    __syncthreads();
    if (threadIdx.x == 0) {
        unsigned* bar = b.bar;
        __builtin_amdgcn_s_waitcnt(0);
        unsigned nloc = b.st[0], nx = b.st[1];
        if (nloc == 0u) { xcd_barrier_complete(bar, b.x, nloc, nx); b.st[0] = nloc; b.st[1] = nx; }
        const unsigned old = xb_add(&bar[XB_XSUB(b.x)], 1u);
        const unsigned gen = old / nloc;
        if (old + 1u == (gen + 1u) * nloc) {
            __builtin_amdgcn_fence(__ATOMIC_RELEASE, "agent");
            asm volatile("s_waitcnt vmcnt(0)" ::: "memory");
            const unsigned og = xb_add(&bar[XB_TOP], 1u);
            const unsigned tg = og / nx;
            if (og + 1u == (tg + 1u) * nx) xb_add(&bar[XB_TOPGEN], 1u);
            else XB_SPIN(xb_ld(&bar[XB_TOPGEN]) == tg, bar);
            __builtin_amdgcn_fence(__ATOMIC_ACQUIRE, "agent");
            xb_add(&bar[XB_XGEN(b.x)], 1u);
            asm volatile("s_waitcnt vmcnt(0)" ::: "memory");
        } else {
            XB_SPIN(xb_ld(&bar[XB_XGEN(b.x)]) == gen, bar);
            __builtin_amdgcn_fence(__ATOMIC_ACQUIRE, "agent");
            asm volatile("s_waitcnt vmcnt(0)" ::: "memory");
        }
    }
    __syncthreads();
}


struct Args { const float* in[13]; float* out; unsigned char* ws; float invf[32]; int lo, hi; };

__global__ void __launch_bounds__(512, 2) fwd_mega(Args args) {
    extern __shared__ __attribute__((aligned(16))) unsigned char lds_raw[];
    LAS unsigned char* lds = (LAS unsigned char*)lds_raw;
    cg::grid_group grid = cg::this_grid();
    const int wave = __builtin_amdgcn_readfirstlane((int)threadIdx.x >> 6);
#define LANE_TID() const int lane = lane_id_asm(), tid = wave * 64 + lane
    const int G = gridDim.x, gw = blockIdx.x * 8 + wave, NGW = G * 8;
    const int lo = args.lo, hi = args.hi;
    volatile LAS unsigned* MISC = (volatile LAS unsigned*)(lds + 131072);
    if (threadIdx.x < 2) MISC[threadIdx.x] = 0u;
    __syncthreads();
    if (hi > NPHASE + 1) grid.sync();
    const XcdBarrier xbar = xcd_barrier_post((unsigned*)(args.ws + WS_CTL) + CW_XBAR, MISC);
#define IN(k) (lo <= (k) && (k) < hi)
#define WSP(T, off) ((T*)(args.ws + (off)))
#define SEAM(k) do { if (IN(k) && IN((k) + 1)) xcd_barrier(xbar); } while (0)

    for (int rep_ = 0; rep_ < NREP(0); ++rep_) { if (rep_) xcd_barrier(xbar);
    if (IN(0)) {
        LANE_TID(); (void)tid;
        LAS float* scr = (LAS float*)(lds + wave * 16384);
        const float* x = args.in[0]; const float* g_pre_mix = args.in[1]; const float* w_in = args.in[2];
        bf16_t* WinT = WSP(bf16_t, WS_WIN); float* tab = WSP(float, WS_TAB); bf16_t* Hb = WSP(bf16_t, WS_H);
        constexpr int I_IN = (D / 64) * (NIN / 32);
        {
            const int nfull = (I_IN / NGW) * NGW;
            for (int it = gw; it < nfull; it += NGW) transpose_item<1>(w_in, D, NIN, WinT, scr, it, lane);
            for (int it = nfull + (int)blockIdx.x; it < I_IN; it += G) transpose_sub<1>(w_in, D, NIN, WinT, scr, it, wave, lane);
        }
        for (int e = blockIdx.x * 512 + tid; e < S * 32; e += G * 512) {
            const int pos = e >> 5, f = e & 31;
            const float ang = (float)pos * args.invf[f];
            const double rev = (double)ang * 0.15915494309189535;
            const float fr = (float)(rev - floor(rev));
            tab[2 * e] = __builtin_amdgcn_cosf(fr); tab[2 * e + 1] = __builtin_amdgcn_sinf(fr);
        }
        {
            f32x4 gq[4];
#pragma unroll
            for (int j = 0; j < 4; ++j) gq[j] = ((const f32x4*)g_pre_mix)[lane + 64 * j];
            for (int m = gw; m < S; m += 2 * NGW) {
                const int m2 = m + NGW;
                const f32x4* xa = (const f32x4*)(x + (size_t)m * D) + lane; const f32x4* xb = (const f32x4*)(x + (size_t)(m2 < S ? m2 : m) * D) + lane;
                f32x4 va[4], vb[4]; float sa = 0.f, sb = 0.f;
#pragma unroll
                for (int j = 0; j < 4; ++j) { va[j] = xa[64 * j]; vb[j] = xb[64 * j]; }
#pragma unroll
                for (int j = 0; j < 4; ++j) { sa += (va[j][0] * va[j][0] + va[j][1] * va[j][1]) + (va[j][2] * va[j][2] + va[j][3] * va[j][3]); sb += (vb[j][0] * vb[j][0] + vb[j][1] * vb[j][1]) + (vb[j][2] * vb[j][2] + vb[j][3] * vb[j][3]); }
                const float ra = 1.0f / sqrtf(wave_sum(sa) * (1.0f / D) + EPS), rb = 1.0f / sqrtf(wave_sum(sb) * (1.0f / D) + EPS);
                u32x2* oa = (u32x2*)(Hb + (size_t)m * D) + lane; u32x2* ob = (u32x2*)(Hb + (size_t)m2 * D) + lane;
#pragma unroll
                for (int j = 0; j < 4; ++j) { u32x2 w; w.x = pk2(va[j][0] * ra * gq[j][0], va[j][1] * ra * gq[j][1]); w.y = pk2(va[j][2] * ra * gq[j][2], va[j][3] * ra * gq[j][3]); oa[64 * j] = w; }
                if (m2 < S) {
#pragma unroll
                    for (int j = 0; j < 4; ++j) { u32x2 w; w.x = pk2(vb[j][0] * rb * gq[j][0], vb[j][1] * rb * gq[j][1]); w.y = pk2(vb[j][2] * rb * gq[j][2], vb[j][3] * rb * gq[j][3]); ob[64 * j] = w; }
                }
            }
        }
    } }
    SEAM(0);

    for (int rep_ = 0; rep_ < NREP(1); ++rep_) { if (rep_) xcd_barrier(xbar);
    if (IN(1)) {
        LANE_TID(); (void)tid;
        pg8::Gemm g{WSP(bf16_t, WS_H), WSP(bf16_t, WS_WIN), S, NIN, D}; pg8::StaticOrder So; So.init(S, NIN, G, (int)blockIdx.x);
        EpiIn E{WSP(bf16_t, WS_QKV), WSP(bf16_t, WS_U), WSP(bf16_t, WS_GATES), WSP(float, WS_TAB)};
        pg8::gemm_phase<EpiIn, pg8::StaticOrder, true, true>(lds, g, So, E, wave, lane);
        {
            const int nwg = (S / 256) * (NIN / 256), rem = nwg % G;
            const bool helper = (rem == 0) || ((int)blockIdx.x >= rem);
            if (helper) {
                const int nh = (rem == 0) ? G : G - rem, hid = (rem == 0) ? (int)blockIdx.x : (int)blockIdx.x - rem;
                const float* w_mix = args.in[3]; const float* w_pa = args.in[5]; const float* w_pp = args.in[6]; const float* w_out = args.in[7]; const float* w_gu = args.in[10]; const float* w_down = args.in[11];
                bf16_t* WpaT = WSP(bf16_t, WS_WPA); bf16_t* WoutT = WSP(bf16_t, WS_WOUT); bf16_t* WguT = WSP(bf16_t, WS_WGU); bf16_t* WdT = WSP(bf16_t, WS_WD); bf16_t* WmT = WSP(bf16_t, WS_WMT);
                LAS float* scr = (LAS float*)(lds + wave * 16384);
                constexpr int I_PA = (256 / 64) * (D / 32), I_OUT = (D / 64) * (D / 32), I_GU = (D / 64) * (NGU / 32), I_DN = (FFH / 64) * (D / 32), I_MX = 4 * 2;
                constexpr int NDEF = 2 * I_PA + I_OUT + I_GU + I_DN + I_MX;
                for (int it = hid * 8 + wave; it < NDEF; it += nh * 8) {
                    int r = it;
                    if (r < I_MX) { const int gg = r >> 1; transpose_item<0>(w_mix + gg * 4096, 64, 64, WmT + gg * 4096, scr, r & 1, lane); continue; } r -= I_MX;
                    if (r < I_PA) { transpose_item<0>(w_pa, 256, D, WpaT, scr, r, lane, 512); continue; } r -= I_PA;
                    if (r < I_PA) { transpose_item<0>(w_pp, 256, D, WpaT + 256, scr, r, lane, 512); continue; } r -= I_PA;
                    if (r < I_OUT) { transpose_item<0>(w_out, D, D, WoutT, scr, r, lane); continue; } r -= I_OUT;
                    if (r < I_GU) { transpose_item<2>(w_gu, D, NGU, WguT, scr, r, lane); continue; } r -= I_GU;
                    transpose_item<0>(w_down, FFH, D, WdT, scr, r, lane);
                }
            }
        }
    } }
    SEAM(1);

    for (int rep_ = 0; rep_ < NREP(2); ++rep_) { if (rep_) xcd_barrier(xbar);
    if (IN(2)) {
        LANE_TID(); (void)tid;
        constexpr int RS = 192, NU = NHEAD * 128;
        const bf16_t* QKV = WSP(bf16_t, WS_QKV); const bf16_t* Ub = WSP(bf16_t, WS_U); bf16_t* OG = WSP(bf16_t, WS_OG); float* LSE = WSP(float, WS_LSE); bf16_t* YP = WSP(bf16_t, WS_OA);
        const bf16_t* WmT = WSP(bf16_t, WS_WMT); const float* pool_scale = args.in[4];
        LAS unsigned char* Kl = lds; LAS unsigned char* Vl = lds + 272 * RS;
        const int c = lane & 15, q = lane >> 4;
        const int rq = tid >> 3, ch = tid & 7, chs = ch ^ ((rq >> 2) & 3);
        for (int i = tid; i < 2 * 768; i += 512) { LAS unsigned char* base = (i < 768) ? Kl : Vl; const int j = (i < 768) ? i : i - 768; *(LAS unsigned*)(base + 256 * RS + 4 * j) = 0u; }
#define AU_OF(un_, h_, row0_, sh_, first_) const int h_ = (un_) >> 7, row0_ = ((un_) & 127) * 128, sh_ = 2 * (h_ >> 2); const bool first_ = (row0_ & ((S >> sh_) - 1)) == 0
#define KV_LOAD(kv, h_, row0_, first_) do { const bf16_t* pk_ = QKV + ((size_t)(NHEAD + (h_)) * S + ((row0_) - 128 + rq)) * HD + 8 * ch; const bf16_t* pv_ = QKV + ((size_t)(2 * NHEAD + (h_)) * S + ((row0_) - 128 + rq)) * HD + 8 * ch; \
            _Pragma("unroll") for (int i_ = 0; i_ < 4; ++i_) { if (i_ >= 2 || !(first_)) { kv[i_] = *(const u32x4*)(pk_ + (size_t)i_ * 64 * HD); kv[4 + i_] = *(const u32x4*)(pv_ + (size_t)i_ * 64 * HD); } \
                else { kv[i_] = (u32x4){0u, 0u, 0u, 0u}; kv[4 + i_] = (u32x4){0u, 0u, 0u, 0u}; } } } while (0)
#define KV_WRITE(kv) do { _Pragma("unroll") for (int i_ = 0; i_ < 4; ++i_) { *(LAS u32x4*)(Kl + (64 * i_ + rq) * RS + chs * 16) = kv[i_]; *(LAS u32x4*)(Vl + (64 * i_ + rq) * RS + chs * 16) = kv[4 + i_]; } } while (0)
#define Q_LOAD(qf, h_, row0_) do { const bf16_t* Qp_ = QKV + ((size_t)(h_) * S + ((row0_) + 16 * wave + c)) * HD + 8 * q; qf[0] = __builtin_nontemporal_load((const bf16x8*)Qp_); qf[1] = __builtin_nontemporal_load((const bf16x8*)(Qp_ + 32)); } while (0)
        typedef short s16x4 __attribute__((ext_vector_type(4)));
        u32x4 kv[8]; bf16x8 qf[2], qn[2];
        int un = blockIdx.x;
        if (un < NU) { AU_OF(un, h0, r0, s0, f0); (void)s0; KV_LOAD(kv, h0, r0, f0); Q_LOAD(qf, h0, r0); }
        for (; un < NU; un += G) {
            AU_OF(un, h, row0, sh, first);
            const int un2 = un + G; const bool has2 = un2 < NU;
            AU_OF((has2 ? un2 : un), h2, row2, sh2, first2); (void)sh2;
            __syncthreads();
            KV_WRITE(kv);
            __syncthreads();
            if (has2) { KV_LOAD(kv, h2, row2, first2); Q_LOAD(qn, h2, row2); }
            const int L = S >> sh;
            {
                const int qrow = row0 + 16 * wave + c;
                f32x4 sc[10];
#pragma unroll
                for (int t = 0; t < 10; ++t) {
                    const int krow = 16 * wave + 32 * (t >> 1) + 8 * (c >> 2) + 4 * (t & 1) + (c & 3);
                    const int kx = (q ^ ((2 * (c >> 2) + (t & 1)) & 3)) * 16;
                    const bf16x8 k0 = *(const LAS bf16x8*)(Kl + krow * RS + kx), k1 = *(const LAS bf16x8*)(Kl + krow * RS + 64 + kx);
                    f32x4 a = (f32x4){0.f, 0.f, 0.f, 0.f};
                    a = __builtin_amdgcn_mfma_f32_16x16x32_bf16(k0, qf[0], a, 0, 0, 0);
                    a = __builtin_amdgcn_mfma_f32_16x16x32_bf16(k1, qf[1], a, 0, 0, 0);
                    sc[t] = a;
                }
                const int ql = 128 + 16 * wave + c;
                float mx = -1e30f;
#pragma unroll
                for (int t = 0; t < 10; ++t)
#pragma unroll
                    for (int rg = 0; rg < 4; ++rg) {
                        const int kl = 16 * wave + 32 * (t >> 1) + 8 * q + 4 * (t & 1) + rg, dist = ql - kl;
                        const bool valid = dist >= 0 && dist <= 128 && (kl >= 128 || !first);
                        const float sv = valid ? sc[t][rg] * 0.18033688011112042f : -1e30f;
                        sc[t][rg] = sv; mx = fmaxf(mx, sv);
                    }
                mx = fmaxf(mx, __shfl_xor(mx, 16)); mx = fmaxf(mx, __shfl_xor(mx, 32));
                float lsum = 0.f;
#pragma unroll
                for (int t = 0; t < 10; ++t)
#pragma unroll
                    for (int rg = 0; rg < 4; ++rg) { const float pv = __builtin_amdgcn_exp2f(sc[t][rg] - mx); sc[t][rg] = pv; lsum += pv; }
                lsum += __shfl_xor(lsum, 16); lsum += __shfl_xor(lsum, 32);
                f32x4 o[4];
#pragma unroll
                for (int dt = 0; dt < 4; ++dt) o[dt] = (f32x4){0.f, 0.f, 0.f, 0.f};
#pragma unroll
                for (int cc = 0; cc < 5; ++cc) {
                    u32x4 pw; pw.x = pk2(sc[2 * cc][0], sc[2 * cc][1]); pw.y = pk2(sc[2 * cc][2], sc[2 * cc][3]); pw.z = pk2(sc[2 * cc + 1][0], sc[2 * cc + 1][1]); pw.w = pk2(sc[2 * cc + 1][2], sc[2 * cc + 1][3]);
                    const bf16x8 pf = __builtin_bit_cast(bf16x8, pw);
                    LAS unsigned char* vb = Vl + (16 * wave + 32 * cc + 8 * q + (c >> 2)) * RS + 8 * (c & 1);
                    const int px = (c >> 1) & 1, x0 = (2 * q) & 3, x1 = (2 * q + 1) & 3;
#pragma unroll
                    for (int dt = 0; dt < 4; ++dt) {
                        const s16x4 v0 = __builtin_bit_cast(s16x4, __builtin_amdgcn_ds_read_tr16_b64_v4i16((LAS s16x4*)(vb + 16 * ((2 * dt + px) ^ x0))));
                        const s16x4 v1 = __builtin_bit_cast(s16x4, __builtin_amdgcn_ds_read_tr16_b64_v4i16((LAS s16x4*)(vb + 4 * RS + 16 * ((2 * dt + px) ^ x1))));
                        bf16x8 vf; vf[0] = v0[0]; vf[1] = v0[1]; vf[2] = v0[2]; vf[3] = v0[3]; vf[4] = v1[0]; vf[5] = v1[1]; vf[6] = v1[2]; vf[7] = v1[3];
                        o[dt] = __builtin_amdgcn_mfma_f32_16x16x32_bf16(vf, pf, o[dt], 0, 0, 0);
                    }
                }
                const float inv = 1.0f / lsum;
                const int tok = ((qrow & (L - 1)) << sh) + (qrow >> (14 - sh));
                bf16_t* op = OG + ((size_t)h * S + tok) * HD + 4 * q;
#pragma unroll
                for (int dt = 0; dt < 4; ++dt) { u32x2 w; w.x = pk2(o[dt][0] * inv, o[dt][1] * inv); w.y = pk2(o[dt][2] * inv, o[dt][3] * inv); *(u32x2*)(op + 16 * dt) = w; }
                if (q == 0) LSE[(size_t)h * S + tok] = (mx + __log2f(lsum)) * 0.6931471805599453f;
            }
            qf[0] = qn[0]; qf[1] = qn[1];
        }
#undef AU_OF
#undef KV_LOAD
#undef KV_WRITE
#undef Q_LOAD
        for (int wu = gw; wu < (S / 16) * 4; wu += NGW) {
            const int tt = wu >> 2, g = wu & 3;
            if (g == 0) pool_unit<2>(Ub, WmT, pool_scale, YP, tt, 0, c, q);
            else if (g == 1) pool_unit<4>(Ub, WmT, pool_scale, YP, tt, 1, c, q);
            else if (g == 2) pool_unit<8>(Ub, WmT, pool_scale, YP, tt, 2, c, q);
            else pool_unit<16>(Ub, WmT, pool_scale, YP, tt, 3, c, q);
        }
    } }
    SEAM(2);

    for (int rep_ = 0; rep_ < NREP(3); ++rep_) { if (rep_) xcd_barrier(xbar);
    if (IN(3)) {
        LANE_TID(); (void)tid;
        const bf16_t* OG = WSP(bf16_t, WS_OG); const float* LSE = WSP(float, WS_LSE); bf16_t* OA = WSP(bf16_t, WS_OA);
        for (int e0 = blockIdx.x * 512 + tid; e0 < S * 32; e0 += 4 * G * 512) {
            float l0[4], l1[4], l2[4]; u32x4 v0[4], v1[4], v2[4];
#pragma unroll
            for (int k = 0; k < 4; ++k) {
                const int e = e0 + k * G * 512, ec = e < S * 32 ? e : e0;
                const int d8 = ec & 7, j = (ec >> 3) & 3, t = ec >> 5;
                l0[k] = LSE[(size_t)(0 + j) * S + t]; l1[k] = LSE[(size_t)(4 + j) * S + t]; l2[k] = LSE[(size_t)(8 + j) * S + t];
                v0[k] = __builtin_nontemporal_load((const u32x4*)(OG + ((size_t)(0 + j) * S + t) * HD + 8 * d8)); v1[k] = __builtin_nontemporal_load((const u32x4*)(OG + ((size_t)(4 + j) * S + t) * HD + 8 * d8)); v2[k] = __builtin_nontemporal_load((const u32x4*)(OG + ((size_t)(8 + j) * S + t) * HD + 8 * d8));
            }
#pragma unroll
            for (int k = 0; k < 4; ++k) {
                const int e = e0 + k * G * 512;
                if (e < S * 32) {
                    const int d8 = e & 7, j = (e >> 3) & 3, t = e >> 5;
                    const float mx = fmaxf(l0[k], fmaxf(l1[k], l2[k]));
                    float w0 = __expf(l0[k] - mx), w1 = __expf(l1[k] - mx), w2 = __expf(l2[k] - mx);
                    const float inv = __builtin_amdgcn_rcpf(w0 + w1 + w2); w0 *= inv; w1 *= inv; w2 *= inv;
                    u32x4 o;
#pragma unroll
                    for (int i = 0; i < 4; ++i) {
                        const float a = w0 * bf2f(v0[k][i] & 0xffffu) + w1 * bf2f(v1[k][i] & 0xffffu) + w2 * bf2f(v2[k][i] & 0xffffu);
                        const float bb = w0 * bf2f(v0[k][i] >> 16) + w1 * bf2f(v1[k][i] >> 16) + w2 * bf2f(v2[k][i] >> 16);
                        o[i] = pk2(a, bb);
                    }
                    *(u32x4*)(OA + (size_t)t * 512 + 64 * j + 8 * d8) = o;
                }
            }
        }
    } }
    SEAM(3);

    for (int rep_ = 0; rep_ < NREP(4); ++rep_) { if (rep_) xcd_barrier(xbar);
    if (IN(4)) {
        LANE_TID(); (void)tid;
        int K1 = 512; asm volatile("" : "+s"(K1));
        pg8::Gemm g{WSP(bf16_t, WS_OA), WSP(bf16_t, WS_WPA), S, D, K1}; pg8::StaticOrder So; So.init(S, D, G, (int)blockIdx.x);
        EpiGate2 E{WSP(bf16_t, WS_GATES), WSP(bf16_t, WS_H)};
        pg8::gemm_phase<EpiGate2, pg8::StaticOrder, true, true>(lds, g, So, E, wave, lane);
    } }
    SEAM(4);

    { const int rep_ = 0; (void)rep_;
    if (IN(5)) {
        LANE_TID(); (void)tid;
        pg8::Gemm g{WSP(bf16_t, WS_H), WSP(bf16_t, WS_WOUT), S, D, D}; pg8::StaticOrder So; So.init(S, D, G, (int)blockIdx.x);
        RowStats st1{WSP(unsigned, WS_XBUF + (size_t)rep_ * 786432), WSP(unsigned, WS_CTL) + (rep_ ? 20480 : 1024)}; RowStats st2{WSP(unsigned, WS_XBUF + 262144 + (size_t)rep_ * 786432), WSP(unsigned, WS_CTL) + (rep_ ? 20480 : 1024) + 4096};
        EpiRmsResRms E{args.in[0], WSP(bf16_t, WS_X1), WSP(bf16_t, WS_H2), args.in[8], args.in[9], st1, st2};
        pg8::gemm_phase<EpiRmsResRms, pg8::StaticOrder, false, true>(lds, g, So, E, wave, lane);
    } }
    SEAM(5);

    for (int rep_ = 0; rep_ < NREP(7); ++rep_) { if (rep_) xcd_barrier(xbar);
    if (IN(7)) {
        LANE_TID(); (void)tid;
        pg8::Gemm g{WSP(bf16_t, WS_H2), WSP(bf16_t, WS_WGU), S, NGU, D}; pg8::StaticOrder So; So.init(S, NGU, G, (int)blockIdx.x);
        EpiSwiglu E{WSP(bf16_t, WS_ACT)};
        pg8::gemm_phase<EpiSwiglu, pg8::StaticOrder, true, true>(lds, g, So, E, wave, lane);
    } }
    SEAM(7);

    { const int rep_ = 0; (void)rep_;
    if (IN(8)) {
        LANE_TID(); (void)tid;
        pg8::Gemm g{WSP(bf16_t, WS_ACT), WSP(bf16_t, WS_WD), S, D, FFH}; pg8::StaticOrder So; So.init(S, D, G, (int)blockIdx.x);
        RowStats st{WSP(unsigned, WS_XBUF + 2 * 262144 + (size_t)rep_ * 786432), WSP(unsigned, WS_CTL) + (rep_ ? 20480 : 1024) + 2 * 4096};
        EpiRmsRes E{WSP(bf16_t, WS_X1), args.out, args.in[12], st};
        pg8::gemm_phase<EpiRmsRes, pg8::StaticOrder, false, true>(lds, g, So, E, wave, lane);
    } }
#undef IN
#undef LANE_TID
#undef WSP
#undef SEAM
}

extern "C" void kernel_launch(void* const* d_in, const int* in_sizes, int n_in, void* d_out, int out_size, void* d_ws, size_t ws_size, hipStream_t stream) {
    static int grid = 0;
    if (grid == 0) {
        if (n_in != 13 || in_sizes[0] != S * D || out_size != S * D || ws_size < WS_END) { fprintf(stderr, "kernel_launch: unexpected shapes (n_in %d, in0 %d, out %d, ws %zu)\n", n_in, n_in > 0 ? in_sizes[0] : -1, out_size, ws_size); grid = -1; return; }
        int dev = 0, cus = 0, per_cu = 0;
        (void)hipGetDevice(&dev);
        (void)hipDeviceGetAttribute(&cus, hipDeviceAttributeMultiprocessorCount, dev);
        if (hipFuncSetAttribute((const void*)fwd_mega, hipFuncAttributeMaxDynamicSharedMemorySize, LDS_BYTES) != hipSuccess) fprintf(stderr, "kernel_launch: hipFuncSetAttribute failed\n");
        if (hipOccupancyMaxActiveBlocksPerMultiprocessor(&per_cu, (const void*)fwd_mega, 512, LDS_BYTES) != hipSuccess || per_cu < 1) { fprintf(stderr, "kernel_launch: occupancy query says %d\n", per_cu); per_cu = 1; }
        (void)hipGetLastError();
        if (cus <= 0) cus = 256;
        grid = cus * per_cu;
    }
    if (grid < 0) return;
    Args a{};
    for (int i = 0; i < 13; ++i) a.in[i] = (const float*)d_in[i];
    a.out = (float*)d_out; a.ws = (unsigned char*)d_ws;
    for (int f = 0; f < 32; ++f) a.invf[f] = (float)pow(10000.0, -(double)f / 32.0);
    a.lo = 0; a.hi = NPHASE;
    (void)hipMemsetAsync((unsigned char*)d_ws + WS_CTL, 0, CTL_ZERO_BYTES, stream);
    void* kargs[] = {&a};
    hipError_t e = hipLaunchCooperativeKernel((const void*)fwd_mega, dim3(grid), dim3(512), kargs, LDS_BYTES, stream);
    if (e != hipSuccess) fprintf(stderr, "kernel_launch: cooperative launch failed: %s (grid %d)\n", hipGetErrorString(e), grid);
}
```

```cpp
#include <hip/hip_runtime.h>
#include <hip/hip_cooperative_groups.h>
#include <cstdio>
#include <cstdint>
#include <cmath>
namespace cg = cooperative_groups;
namespace pg8 {
#define PG8_LAS __attribute__((address_space(3)))
typedef unsigned short bf16_t;
typedef short bf16x8 __attribute__((ext_vector_type(8)));
typedef float f32x4 __attribute__((ext_vector_type(4)));
typedef unsigned u32x4 __attribute__((ext_vector_type(4)));
constexpr int BM = 256, BK = 64, HALF = 128, HTB = HALF * BK * 2  , STAGE_BYTES = 8 * HTB, NXCD = 8, WGM = 8;

__host__ __device__ __forceinline__ int lds_byte(int r, int c) { const int st = (r >> 4) * 2 + (c >> 5), rr = r & 15, cc = c & 31, ob = rr * 64 + cc * 2; return st * 1024 + (ob ^ (((ob >> 9) & 1) << 5)); }
__host__ __device__ __forceinline__ void stage_rc(int b, int& R, int& C) { const int st = b / 1024, sb = b % 1024, swz = sb ^ (((sb >> 9) & 1) << 5); R = (st >> 1) * 16 + swz / 64; C = (st & 1) * 32 + (swz % 64) / 2; }
__host__ __device__ __forceinline__ int perm32(int rho) { const int n = rho >> 4, i = rho & 15; return 8 * (i >> 2) + 4 * n + (i & 3); }

struct Unit { int pm, pn; };
struct Gemm { const bf16_t* A; const bf16_t* Bt; int M, N, K; };

struct StaticOrder {
    int nM, nN, nwg, G, c;
    __host__ __device__ void init(int M, int N, int G_, int c_) { nM = M / BM; nN = N / BM; nwg = nM * nN; G = G_; c = c_; }
    __host__ __device__ bool next(int i, Unit& u) const {
        const long L = (long)i * G + c; if (L >= nwg) return false;
        int wgid = (int)L; { const int q = nwg / NXCD, r = nwg % NXCD, xcd = wgid % NXCD, off = wgid / NXCD; wgid = (xcd < r ? xcd * (q + 1) : r * (q + 1) + (xcd - r) * q) + off; }
        const int nig = WGM * nN, gid = wgid / nig, fm = gid * WGM, gsz = (nM - fm) < WGM ? (nM - fm) : WGM;
        u.pm = fm + ((wgid % nig) % gsz); u.pn = (wgid % nig) / gsz; return true;
    }
    __device__ __forceinline__ void a_ready(const Unit&) const {}
    __device__ __forceinline__ void done(const Unit&) const {}
};
__device__ __forceinline__ unsigned cvt_pk_bf16(float lo, float hi) { unsigned r; asm volatile("v_cvt_pk_bf16_f32 %0, %1, %2" : "=v"(r) : "v"(lo), "v"(hi)); return r; }
typedef float f32x2 __attribute__((ext_vector_type(2)));
template <class Epi, class Sched, bool ALIGN_EPI = false, bool SP2 = false>
__device__ __forceinline__ void gemm_phase(PG8_LAS unsigned char* lds, const Gemm g, const Sched& S, const Epi& E, const int wid, const int lane) {
    const int tid = wid * 64 + lane, wr = wid >> 2, wc = wid & 3, fr = lane & 15, fq = lane >> 4;
    const int K = g.K, nt = K / BK;
    unsigned voffA[2], voffB[2];
#pragma unroll
    for (int i = 0; i < 2; ++i) { int R, C; stage_rc(tid * 16 + i * 8192, R, C); const int Rb = Epi::PERM ? ((R & ~31) + perm32(R & 31)) : R;
        voffA[i] = (unsigned)(R * K + C) * 2u; voffB[i] = (unsigned)(Rb * K + C) * 2u; }
    const size_t kstep = (size_t)(BK * 2);
    const size_t hstep = (size_t)HALF * K * 2;
    const size_t tstep = 2 * hstep;
    const unsigned ldsw = (unsigned)wid * 1024u;
    const int aoff = lds_byte(wr * 64 + fr, fq * 8), boff = lds_byte(wc * 32 + fr, fq * 8);
#define PG8_SA(b, h) (((b) * 2 + (h)) * HTB)
#define PG8_SB(b, h) ((4 + (b) * 2 + (h)) * HTB)
#define PG8_STAGE(bufoff, gbase, voff) do { _Pragma("unroll") for (int _i = 0; _i < 2; ++_i) \
        __builtin_amdgcn_global_load_lds((const unsigned*)((const char*)(gbase) + (voff)[_i]), (PG8_LAS unsigned*)(lds + (bufoff) + ldsw + _i * 8192), 16, 0, 0); } while (0)
#define PG8_LDA(dst, b, h) do { _Pragma("unroll") for (int m = 0; m < 4; ++m) _Pragma("unroll") for (int k = 0; k < 2; ++k) dst[m][k] = *(const PG8_LAS bf16x8*)(lds + PG8_SA(b, h) + aoff + m * 2048 + k * 1024); } while (0)
#define PG8_LDB(dst, b, h) do { _Pragma("unroll") for (int n = 0; n < 2; ++n) _Pragma("unroll") for (int k = 0; k < 2; ++k) dst[n][k] = *(const PG8_LAS bf16x8*)(lds + PG8_SB(b, h) + boff + n * 2048 + k * 1024); } while (0)
#define PG8_MMA(ai, bj, At, Bt) do { __builtin_amdgcn_s_setprio(1); _Pragma("unroll") for (int m = 0; m < 4; ++m) _Pragma("unroll") for (int n = 0; n < 2; ++n) _Pragma("unroll") for (int k = 0; k < 2; ++k) \
        acc[ai][bj][m][n] = __builtin_amdgcn_mfma_f32_16x16x32_bf16(Bt[n][k], At[m][k], acc[ai][bj][m][n], 0, 0, 0); __builtin_amdgcn_s_setprio(0); } while (0)
#define PG8_WAIT_V(n) asm volatile("s_waitcnt vmcnt(" #n ")" ::: "memory")
#define PG8_WAIT_L(n) asm volatile("s_waitcnt lgkmcnt(" #n ")" ::: "memory")
#define PG8_BAR __builtin_amdgcn_s_barrier()
#define PG8_SCHED __builtin_amdgcn_sched_barrier(0)
    Unit cur, nxt; int ui = 0;
    if (!S.next(0, cur)) return;
    f32x4 acc[2][2][4][2];
#pragma unroll
    for (int a = 0; a < 2; ++a)
#pragma unroll
        for (int b = 0; b < 2; ++b)
#pragma unroll
            for (int m = 0; m < 4; ++m)
#pragma unroll
                for (int n = 0; n < 2; ++n) acc[a][b][m][n] = (f32x4){0.f, 0.f, 0.f, 0.f};
    bf16x8 At[4][2], B0[2][2], B1[2][2];
    const char* cA = (const char*)g.A + (size_t)cur.pm * tstep; const char* cB = (const char*)g.Bt + (size_t)cur.pn * tstep;
    S.a_ready(cur);
    if constexpr (SP2) {
        PG8_STAGE(PG8_SB(0, 0), cB, voffB); PG8_STAGE(PG8_SB(0, 1), cB + hstep, voffB); PG8_STAGE(PG8_SA(0, 0), cA, voffA); PG8_STAGE(PG8_SA(0, 1), cA + hstep, voffA);
        if (wr == 1) PG8_BAR;
        PG8_WAIT_V(2); PG8_BAR;
        PG8_STAGE(PG8_SB(1, 0), cB + kstep, voffB); PG8_STAGE(PG8_SA(1, 0), cA + kstep, voffA); PG8_STAGE(PG8_SB(1, 1), cB + hstep + kstep, voffB);
        PG8_WAIT_V(6); PG8_BAR;
    } else {
        PG8_STAGE(PG8_SB(0, 0), cB, voffB); PG8_STAGE(PG8_SA(0, 0), cA, voffA); PG8_STAGE(PG8_SB(0, 1), cB + hstep, voffB); PG8_STAGE(PG8_SA(0, 1), cA + hstep, voffA);
        if (wr == 1) PG8_BAR;
        PG8_WAIT_V(4); PG8_BAR;
        PG8_STAGE(PG8_SB(1, 0), cB + kstep, voffB); PG8_STAGE(PG8_SA(1, 0), cA + kstep, voffA); PG8_STAGE(PG8_SB(1, 1), cB + hstep + kstep, voffB);
        PG8_WAIT_V(6); PG8_BAR;
    }
    for (;;) {
        const bool has_next = S.next(ui + 1, nxt);
        const char* nA = has_next ? (const char*)g.A + (size_t)nxt.pm * tstep : cA; const char* nB = has_next ? (const char*)g.Bt + (size_t)nxt.pn * tstep : cB;
        for (int t = 0; t < nt; t += 2) {
            if constexpr (Epi::HAS_MID) { if (t == (nt >> 1)) E.mid(acc, cur, wr, wc, fr, fq); }
            const bool last = (t == nt - 2);
            const char* a1 = cA + (size_t)(t + 1) * kstep;
            const char* a2 = last ? nA : cA + (size_t)(t + 2) * kstep; const char* b2 = last ? nB : cB + (size_t)(t + 2) * kstep;
            const char* a3 = a2 + kstep; const char* b3 = b2 + kstep;
            if (last && has_next) S.a_ready(nxt);
            if constexpr (SP2) {
            PG8_LDB(B0, 0, 0); PG8_LDB(B1, 0, 1); PG8_SCHED; PG8_LDA(At, 0, 0); PG8_STAGE(PG8_SA(1, 1), a1 + hstep, voffA);
            PG8_WAIT_V(8); PG8_WAIT_L(0); PG8_BAR; PG8_MMA(0, 0, At, B0); PG8_MMA(0, 1, At, B1); PG8_BAR; PG8_SCHED;
            PG8_LDA(At, 0, 1); PG8_STAGE(PG8_SB(0, 0), b2, voffB); PG8_STAGE(PG8_SB(0, 1), b2 + hstep, voffB); PG8_STAGE(PG8_SA(0, 0), a2, voffA);
            PG8_WAIT_V(8); PG8_WAIT_L(0); PG8_BAR; PG8_MMA(1, 0, At, B0); PG8_MMA(1, 1, At, B1); PG8_BAR; PG8_SCHED;
            PG8_LDB(B0, 1, 0); PG8_LDB(B1, 1, 1); PG8_SCHED; PG8_LDA(At, 1, 0); PG8_STAGE(PG8_SA(0, 1), a2 + hstep, voffA);
            PG8_WAIT_V(8); PG8_WAIT_L(0); PG8_BAR; PG8_MMA(0, 0, At, B0); PG8_MMA(0, 1, At, B1); PG8_BAR; PG8_SCHED;
            PG8_LDA(At, 1, 1); PG8_STAGE(PG8_SB(1, 0), b3, voffB); PG8_STAGE(PG8_SB(1, 1), b3 + hstep, voffB); PG8_STAGE(PG8_SA(1, 0), a3, voffA);
            PG8_WAIT_V(8); PG8_WAIT_L(0); PG8_BAR; PG8_MMA(1, 0, At, B0); PG8_MMA(1, 1, At, B1); PG8_BAR; PG8_SCHED;
            } else {
            PG8_LDB(B0, 0, 0); PG8_SCHED; PG8_LDA(At, 0, 0); PG8_STAGE(PG8_SA(1, 1), a1 + hstep, voffA);
            PG8_WAIT_L(8); PG8_BAR; PG8_WAIT_L(0); PG8_MMA(0, 0, At, B0); PG8_BAR; PG8_SCHED;
            PG8_LDB(B1, 0, 1); PG8_STAGE(PG8_SB(0, 0), b2, voffB);
            PG8_BAR; PG8_WAIT_L(0); PG8_MMA(0, 1, At, B1); PG8_BAR;
            PG8_LDA(At, 0, 1); PG8_STAGE(PG8_SA(0, 0), a2, voffA);
            PG8_BAR; PG8_WAIT_L(0); PG8_MMA(1, 0, At, B0); PG8_BAR; PG8_SCHED;
            PG8_STAGE(PG8_SB(0, 1), b2 + hstep, voffB);
            PG8_WAIT_V(6); PG8_BAR; PG8_MMA(1, 1, At, B1); PG8_BAR;
            PG8_LDB(B0, 1, 0); PG8_SCHED; PG8_LDA(At, 1, 0); PG8_STAGE(PG8_SA(0, 1), a2 + hstep, voffA);
            PG8_WAIT_L(8); PG8_BAR; PG8_WAIT_L(0); PG8_MMA(0, 0, At, B0); PG8_BAR; PG8_SCHED;
            PG8_LDB(B1, 1, 1); PG8_STAGE(PG8_SB(1, 0), b3, voffB);
            PG8_BAR; PG8_WAIT_L(0); PG8_MMA(0, 1, At, B1); PG8_BAR;
            PG8_LDA(At, 1, 1); PG8_STAGE(PG8_SA(1, 0), a3, voffA);
            PG8_BAR; PG8_WAIT_L(0); PG8_MMA(1, 0, At, B0); PG8_BAR; PG8_SCHED;
            PG8_STAGE(PG8_SB(1, 1), b3 + hstep, voffB);
            PG8_WAIT_V(6); PG8_BAR; PG8_MMA(1, 1, At, B1); PG8_BAR;
            }
        }
        if constexpr (ALIGN_EPI) { if (wr == 0) PG8_BAR; }
        if constexpr (!Epi::AFTER_DRAIN) { E(acc, cur, wr, wc, fr, fq); S.done(cur); }
        if (!has_next) break;
#pragma unroll
        for (int a = 0; a < 2; ++a)
#pragma unroll
            for (int b = 0; b < 2; ++b)
#pragma unroll
                for (int m = 0; m < 4; ++m)
#pragma unroll
                    for (int n = 0; n < 2; ++n) acc[a][b][m][n] = (f32x4){0.f, 0.f, 0.f, 0.f};
        cur = nxt; cA = nA; cB = nB; ++ui;
        if constexpr (ALIGN_EPI) { if (wr == 1) PG8_BAR; }
    }
    PG8_WAIT_V(0);
    if constexpr (!ALIGN_EPI) { if (wr == 0) PG8_BAR; }
    PG8_BAR;
    if constexpr (Epi::AFTER_DRAIN) { E.fused(acc, cur, wr, wc, fr, fq, lds, wid, lane); S.done(cur); }
#undef PG8_SA
#undef PG8_SB
#undef PG8_STAGE
#undef PG8_LDA
#undef PG8_LDB
#undef PG8_MMA
#undef PG8_WAIT_V
#undef PG8_WAIT_L
#undef PG8_BAR
#undef PG8_SCHED
}
}
#ifndef REP_PHASE
#define REP_PHASE -1
#endif
#define NREP(k) ((k) == REP_PHASE ? 2 : 1)

constexpr int S = 16384, D = 1024, NIN = 4608, FFH = 2816, NGU = 2 * FFH;
constexpr int NHEAD = 12, HD = 64;
constexpr float EPS = 1e-6f;
constexpr int LDS_BYTES = 147456;
constexpr int NPHASE = 10;

#define LAS __attribute__((address_space(3)))
typedef unsigned short bf16_t;
typedef short bf16x8 __attribute__((ext_vector_type(8)));
typedef float f32x4 __attribute__((ext_vector_type(4)));
typedef unsigned u32x4 __attribute__((ext_vector_type(4)));
typedef unsigned u32x2 __attribute__((ext_vector_type(2)));

constexpr size_t MiB = 1u << 20;
constexpr size_t WS_WIN = 0;
constexpr size_t WS_WPA = 9 * MiB;
constexpr size_t WS_WOUT = 10 * MiB;
constexpr size_t WS_WGU = 12 * MiB;
constexpr size_t WS_WD = 23 * MiB;
constexpr size_t WS_WMT = 29 * MiB;
constexpr size_t WS_TAB = 30 * MiB;
constexpr size_t WS_H = 34 * MiB;
constexpr size_t WS_QKV = 66 * MiB;
constexpr size_t WS_U = 138 * MiB;
constexpr size_t WS_GATES = 146 * MiB;
constexpr size_t WS_OG = 210 * MiB;
constexpr size_t WS_LSE = 234 * MiB;
constexpr size_t WS_OA = 235 * MiB;
constexpr size_t WS_H2 = 154 * MiB;
constexpr size_t WS_X1 = 186 * MiB;
constexpr size_t WS_ACT = 66 * MiB;
constexpr size_t WS_CTL = 251 * MiB;
constexpr size_t CTL_ZERO_BYTES = 131072;
constexpr int CW_XBAR = 16384;
constexpr size_t WS_XBUF = 251 * MiB + 131072;
constexpr size_t WS_END = (REP_PHASE >= 0 ? 253 : 252) * MiB;

__device__ __forceinline__ float bf2f(unsigned bits16) { return __builtin_bit_cast(float, bits16 << 16); }
typedef float f32x2_t __attribute__((ext_vector_type(2)));
typedef __bf16 bf16x2_t __attribute__((ext_vector_type(2)));
__device__ __forceinline__ unsigned pk2(float lo, float hi) { f32x2_t v = {lo, hi}; bf16x2_t b = __builtin_convertvector(v, bf16x2_t); return __builtin_bit_cast(unsigned, b); }
__device__ __forceinline__ float wave_sum(float v) {
#pragma unroll
    for (int o = 1; o < 64; o <<= 1) v += __shfl_xor(v, o);
    return v;
}
__device__ __forceinline__ int lane_id_asm() { int l; asm volatile("v_mbcnt_lo_u32_b32 %0, -1, 0\n\tv_mbcnt_hi_u32_b32 %0, -1, %0" : "=v"(l)); return l; }
__device__ __forceinline__ float sigmoidf_(float v) { return __builtin_amdgcn_rcpf(1.0f + __builtin_amdgcn_exp2f(v * -1.4426950408889634f)); }

__host__ __device__ __forceinline__ int in_tile(int pn) { return pn < 8 ? pn + 10 : (pn < 14 ? pn - 8 : (pn == 14 ? 9 : pn - 9)); }
#define OPQ(p) asm volatile("" : "+v"(p))
#define EPI_ROWS_BEGIN _Pragma("unroll") for (int ai = 0; ai < 2; ++ai) { _Pragma("unroll") for (int m = 0; m < 4; ++m) {
#define EPI_ROWS_END(step16, step64) } }
struct EpiIn {
    static constexpr bool PERM = true, AFTER_DRAIN = false, HAS_MID = false;
    bf16_t* qkv; bf16_t* ub; bf16_t* gates; const float* tab;
    __device__ __forceinline__ void operator()(const f32x4 (&acc)[2][2][4][2], const pg8::Unit& u, int wr, int wc, int fr, int fq) const {
        const int pn = in_tile(u.pn);
        const int r0 = u.pm * 256 + wr * 64 + fr;
        if (pn < 6) {
            const int T = pn / 3, g3 = pn - 3 * T, sh = 2 * g3;
            const int rowp0 = ((r0 & ((1 << sh) - 1)) << (14 - sh)) + (r0 >> sh);
            bf16_t* dst = qkv + (((size_t)T * NHEAD + g3 * 4 + wc) * S + rowp0) * HD + 8 * fq;
            const float* tp = tab + ((size_t)r0 * 32 + 8 * fq) * 2;
            const int dstep = (16 >> sh) * HD;
#pragma unroll
            for (int ai = 0; ai < 2; ++ai) {
#pragma unroll
                for (int m = 0; m < 4; ++m) {
                    u32x4 w1, w2;
#pragma unroll
                    for (int n = 0; n < 2; ++n) {
                        const f32x4 cs0 = *(const f32x4*)(tp + 8 * n), cs1 = *(const f32x4*)(tp + 8 * n + 4);
                        const f32x4 a = acc[ai][0][m][n], b = acc[ai][1][m][n];
                        const float o10 = a[0] * cs0[0] - b[0] * cs0[1], o20 = b[0] * cs0[0] + a[0] * cs0[1];
                        const float o11 = a[1] * cs0[2] - b[1] * cs0[3], o21 = b[1] * cs0[2] + a[1] * cs0[3];
                        const float o12 = a[2] * cs1[0] - b[2] * cs1[1], o22 = b[2] * cs1[0] + a[2] * cs1[1];
                        const float o13 = a[3] * cs1[2] - b[3] * cs1[3], o23 = b[3] * cs1[2] + a[3] * cs1[3];
                        w1[2 * n] = pk2(o10, o11); w1[2 * n + 1] = pk2(o12, o13); w2[2 * n] = pk2(o20, o21); w2[2 * n + 1] = pk2(o22, o23);
                    }
                    *(u32x4*)dst = w1; *(u32x4*)(dst + 32) = w2;
                    dst += dstep; tp += 16 * 64; OPQ(dst); OPQ(tp);
                }
                dst += 4 * dstep; tp += 64 * 64; OPQ(dst); OPQ(tp);
            }
        } else if (pn < 9) {
            const int g3 = pn - 6, sh = 2 * g3;
            const int rowp0 = ((r0 & ((1 << sh) - 1)) << (14 - sh)) + (r0 >> sh);
            bf16_t* dst = qkv + (((size_t)2 * NHEAD + g3 * 4 + (wc >> 1)) * S + rowp0) * HD + 32 * (wc & 1) + 8 * fq;
            const int dstep = (16 >> sh) * HD;
#pragma unroll
            for (int ai = 0; ai < 2; ++ai) {
#pragma unroll
                for (int m = 0; m < 4; ++m) {
#pragma unroll
                    for (int bj = 0; bj < 2; ++bj) { const f32x4 a0 = acc[ai][bj][m][0], a1 = acc[ai][bj][m][1];
                        u32x4 wv; wv.x = pk2(a0[0], a0[1]); wv.y = pk2(a0[2], a0[3]); wv.z = pk2(a1[0], a1[1]); wv.w = pk2(a1[2], a1[3]); *(u32x4*)(dst + (size_t)bj * 2 * S * HD) = wv; }
                    dst += dstep; OPQ(dst);
                }
                dst += 4 * dstep; OPQ(dst);
            }
        } else if (pn == 9) {
            bf16_t* dst = ub + (size_t)r0 * 256 + 32 * wc + 8 * fq;
#pragma unroll
            for (int ai = 0; ai < 2; ++ai) {
#pragma unroll
                for (int m = 0; m < 4; ++m) {
#pragma unroll
                    for (int bj = 0; bj < 2; ++bj) { const f32x4 a0 = acc[ai][bj][m][0], a1 = acc[ai][bj][m][1];
                        u32x4 wv; wv.x = pk2(a0[0], a0[1]); wv.y = pk2(a0[2], a0[3]); wv.z = pk2(a1[0], a1[1]); wv.w = pk2(a1[2], a1[3]); *(u32x4*)(dst + 128 * bj) = wv; }
                    dst += 16 * 256; OPQ(dst);
                }
                dst += 64 * 256; OPQ(dst);
            }
        } else {
            const int tg = pn - 10, wid = wr * 4 + wc, lane = fq * 16 + fr;
            unsigned char* dst = (unsigned char*)gates + ((size_t)(u.pm * 8 + tg) * 2) * 65536 + (wid * 64 + lane) * 16;
#pragma unroll
            for (int ai = 0; ai < 2; ++ai)
#pragma unroll
                for (int m = 0; m < 4; ++m) {
                    u32x4 w0, w1;
#pragma unroll
                    for (int n = 0; n < 2; ++n) {
                        const f32x4 a = acc[ai][0][m][n], b = acc[ai][1][m][n];
                        f32x4 ra, sp;
#pragma unroll
                        for (int j = 0; j < 4; ++j) { const float pa = 1.0f + __builtin_amdgcn_exp2f(fminf(a[j] * -1.4426950408889634f, 60.0f)), pb = 1.0f + __builtin_amdgcn_exp2f(fminf(b[j] * -1.4426950408889634f, 60.0f));
                            const float rr = __builtin_amdgcn_rcpf(pa * pb);
                            sp[j] = pa * rr; ra[j] = pb * pb * rr; }
                        w0[2 * n] = pk2(ra[0], ra[1]); w0[2 * n + 1] = pk2(ra[2], ra[3]); w1[2 * n] = pk2(sp[0], sp[1]); w1[2 * n + 1] = pk2(sp[2], sp[3]);
                    }
                    *(u32x4*)dst = w0; *(u32x4*)(dst + 65536) = w1;
                    dst += 8192; OPQ(dst);
                }
        }
    }
};

struct EpiGate2 {
    static constexpr bool PERM = true, AFTER_DRAIN = false, HAS_MID = true;
    const bf16_t* gates; bf16_t* merged;
    __device__ __forceinline__ void mid(f32x4 (&acc)[2][2][4][2], const pg8::Unit& u, int wr, int wc, int fr, int fq) const {
        const int wid = wr * 4 + wc, lane = fq * 16 + fr;
#pragma unroll
        for (int bj = 0; bj < 2; ++bj) {
            const unsigned char* gp = (const unsigned char*)gates + ((size_t)(u.pm * 8 + 2 * u.pn + bj) * 2) * 65536 + (wid * 64 + lane) * 16;
#pragma unroll
            for (int ai = 0; ai < 2; ++ai)
#pragma unroll
                for (int m = 0; m < 4; ++m) {
                    const u32x4 ga = __builtin_nontemporal_load((const u32x4*)gp);
#pragma unroll
                    for (int n = 0; n < 2; ++n) { f32x4 ra; ra[0] = bf2f(ga[2 * n] & 0xffffu); ra[1] = bf2f(ga[2 * n] >> 16); ra[2] = bf2f(ga[2 * n + 1] & 0xffffu); ra[3] = bf2f(ga[2 * n + 1] >> 16);
                        acc[ai][bj][m][n] = acc[ai][bj][m][n] * ra; }
                    gp += 8192; OPQ(gp);
                }
        }
    }
    __device__ __forceinline__ void operator()(const f32x4 (&acc)[2][2][4][2], const pg8::Unit& u, int wr, int wc, int fr, int fq) const {
        const int wid = wr * 4 + wc, lane = fq * 16 + fr;
        const int r0 = u.pm * 256 + wr * 64 + fr, c0 = u.pn * 256 + 32 * wc + 8 * fq;
#pragma unroll
        for (int bj = 0; bj < 2; ++bj) {
            const unsigned char* gp = (const unsigned char*)gates + ((size_t)(u.pm * 8 + 2 * u.pn + bj) * 2 + 1) * 65536 + (wid * 64 + lane) * 16;
            bf16_t* mp = merged + (size_t)r0 * D + c0 + 128 * bj;
#pragma unroll
            for (int ai = 0; ai < 2; ++ai) {
#pragma unroll
                for (int m = 0; m < 4; ++m) {
                    const u32x4 gw = __builtin_nontemporal_load((const u32x4*)gp);
                    u32x4 wv;
#pragma unroll
                    for (int n = 0; n < 2; ++n) { f32x4 g; g[0] = bf2f(gw[2 * n] & 0xffffu); g[1] = bf2f(gw[2 * n] >> 16); g[2] = bf2f(gw[2 * n + 1] & 0xffffu); g[3] = bf2f(gw[2 * n + 1] >> 16);
                        const f32x4 o = acc[ai][bj][m][n] * g; wv[2 * n] = pk2(o[0], o[1]); wv[2 * n + 1] = pk2(o[2], o[3]); }
                    *(u32x4*)mp = wv;
                    gp += 8192; OPQ(gp);
                    mp += 16 * D; OPQ(mp);
                }
                mp += 64 * D; OPQ(mp);
            }
        }
    }
};

struct EpiF32 {
    static constexpr bool PERM = false, AFTER_DRAIN = false, HAS_MID = false;
    float* out; int ldc;
    __device__ __forceinline__ void operator()(const f32x4 (&acc)[2][2][4][2], const pg8::Unit& u, int wr, int wc, int fr, int fq) const {
        float* op = out + (size_t)(u.pm * 256 + wr * 64 + fr) * ldc + u.pn * 256 + 32 * wc + 4 * fq;
#pragma unroll
        for (int ai = 0; ai < 2; ++ai) {
#pragma unroll
            for (int m = 0; m < 4; ++m) {
#pragma unroll
                for (int bj = 0; bj < 2; ++bj)
#pragma unroll
                    for (int n = 0; n < 2; ++n) *(f32x4*)(op + 128 * bj + 16 * n) = acc[ai][bj][m][n];
                op += 16 * (size_t)ldc; OPQ(op);
            }
            op += 64 * (size_t)ldc; OPQ(op);
        }
    }
};

struct EpiSwiglu {
    static constexpr bool PERM = true, AFTER_DRAIN = false, HAS_MID = false;
    bf16_t* act;
    __device__ __forceinline__ void operator()(const f32x4 (&acc)[2][2][4][2], const pg8::Unit& u, int wr, int wc, int fr, int fq) const {
        bf16_t* op = act + (size_t)(u.pm * 256 + wr * 64 + fr) * FFH + u.pn * 128 + 32 * wc + 8 * fq;
#pragma unroll
        for (int ai = 0; ai < 2; ++ai) {
#pragma unroll
            for (int m = 0; m < 4; ++m) {
                u32x4 wv;
#pragma unroll
                for (int n = 0; n < 2; ++n) {
                    const f32x4 a = acc[ai][0][m][n], b = acc[ai][1][m][n];
                    f32x4 o;
#pragma unroll
                    for (int j = 0; j < 4; ++j) o[j] = a[j] * sigmoidf_(a[j]) * b[j];
                    wv[2 * n] = pk2(o[0], o[1]); wv[2 * n + 1] = pk2(o[2], o[3]);
                }
                __builtin_nontemporal_store(wv, (u32x4*)op);
                op += 16 * FFH; OPQ(op);
            }
            op += 64 * FFH; OPQ(op);
        }
    }
};

struct RowStats {
    unsigned* xbuf;
    unsigned* cnt;
    __device__ __forceinline__ void run(const f32x4 (&v)[2][2][4][2], const pg8::Unit& u, int wr, int wc, int fr, int fq, LAS unsigned char* lds, int wid, int lane) const {
        LAS float* P = (LAS float*)lds;
        LAS float* Sg = (LAS float*)(lds + 8192);
#pragma unroll
        for (int ai = 0; ai < 2; ++ai)
#pragma unroll
            for (int m = 0; m < 4; ++m) {
                float q = 0.f;
#pragma unroll
                for (int bj = 0; bj < 2; ++bj)
#pragma unroll
                    for (int n = 0; n < 2; ++n) { const f32x4 d = v[ai][bj][m][n]; q += (d[0] * d[0] + d[1] * d[1]) + (d[2] * d[2] + d[3] * d[3]); }
                q += __shfl_xor(q, 16); q += __shfl_xor(q, 32);
                if (fq == 0) P[(ai * 128 + wr * 64 + m * 16 + fr) * 4 + wc] = q;
            }
        asm volatile("s_waitcnt lgkmcnt(0)" ::: "memory"); __builtin_amdgcn_s_barrier(); asm volatile("" ::: "memory");
        const int row = wid * 32 + (lane & 31);
        if (lane < 32) {
            const float tot = (P[row * 4 + 0] + P[row * 4 + 1]) + (P[row * 4 + 2] + P[row * 4 + 3]);
            __hip_atomic_store(xbuf + ((size_t)(u.pm * 256 + row) * 4 + u.pn), __builtin_bit_cast(unsigned, tot), __ATOMIC_RELAXED, __HIP_MEMORY_SCOPE_AGENT);
        }
        asm volatile("s_waitcnt vmcnt(0)" ::: "memory");
        if (lane == 0) __hip_atomic_fetch_add(cnt + 64 * u.pm, 1u, __ATOMIC_RELAXED, __HIP_MEMORY_SCOPE_AGENT);
        if (wid == 0) {
            unsigned spins = 0;
            while ((unsigned)__builtin_amdgcn_readfirstlane(__hip_atomic_load(cnt + 64 * u.pm, __ATOMIC_RELAXED, __HIP_MEMORY_SCOPE_AGENT)) < 32u) {
                __builtin_amdgcn_s_sleep(2); if (++spins > (1u << 22)) break; }
            __builtin_amdgcn_fence(__ATOMIC_ACQUIRE, "agent");
        }
        asm volatile("s_waitcnt vmcnt(0) lgkmcnt(0)" ::: "memory"); __builtin_amdgcn_s_barrier(); asm volatile("" ::: "memory");
        if (lane < 32) {
            const unsigned* slot = xbuf + (size_t)(u.pm * 256 + row) * 4; float t[4];
#pragma unroll
            for (int k = 0; k < 4; ++k) t[k] = __builtin_bit_cast(float, __hip_atomic_load(slot + k, __ATOMIC_RELAXED, __HIP_MEMORY_SCOPE_AGENT));
            Sg[row] = 1.0f / sqrtf(((t[0] + t[1]) + (t[2] + t[3])) * (1.0f / D) + EPS);
        }
        asm volatile("s_waitcnt lgkmcnt(0)" ::: "memory"); __builtin_amdgcn_s_barrier(); asm volatile("" ::: "memory");
    }
};
struct EpiRmsResRms {
    static constexpr bool PERM = true, AFTER_DRAIN = true, HAS_MID = false;
    const float* base; bf16_t* x1b; bf16_t* xn; const float* g1; const float* g2; RowStats st1, st2;
    __device__ __forceinline__ void fused(f32x4 (&acc)[2][2][4][2], const pg8::Unit& u, int wr, int wc, int fr, int fq, LAS unsigned char* lds, int wid, int lane) const {
        const LAS float* Sg = (const LAS float*)(lds + 8192);
        const int col0 = u.pn * 256 + wc * 32 + 8 * fq;
        const float* bp = base + (size_t)(u.pm * 256 + wr * 64 + fr) * D + col0;
        f32x4 pre[4][2][2];
#pragma unroll
        for (int m = 0; m < 4; ++m)
#pragma unroll
            for (int bj = 0; bj < 2; ++bj)
#pragma unroll
                for (int n = 0; n < 2; ++n) pre[m][bj][n] = __builtin_nontemporal_load((const f32x4*)(bp + (size_t)m * 16 * D + bj * 128 + n * 4));
        st1.run(acc, u, wr, wc, fr, fq, lds, wid, lane);
        {
            f32x4 gv[2][2];
#pragma unroll
            for (int bj = 0; bj < 2; ++bj)
#pragma unroll
                for (int n = 0; n < 2; ++n) gv[bj][n] = *(const f32x4*)(g1 + col0 + bj * 128 + n * 4);
#pragma unroll
            for (int ai = 0; ai < 2; ++ai) {
#pragma unroll
                for (int m = 0; m < 4; ++m) {
                    const float r1 = Sg[ai * 128 + wr * 64 + m * 16 + fr];
#pragma unroll
                    for (int bj = 0; bj < 2; ++bj)
#pragma unroll
                        for (int n = 0; n < 2; ++n) { const f32x4 bs = pre[m][bj][n]; acc[ai][bj][m][n] = bs + acc[ai][bj][m][n] * r1 * gv[bj][n]; }
                    if (ai == 0) {
#pragma unroll
                        for (int bj = 0; bj < 2; ++bj)
#pragma unroll
                            for (int n = 0; n < 2; ++n) pre[m][bj][n] = __builtin_nontemporal_load((const f32x4*)(bp + (size_t)128 * D + bj * 128 + n * 4));
                    }
                    asm volatile("" : "+v"(acc[ai][0][m][0]), "+v"(acc[ai][0][m][1]), "+v"(acc[ai][1][m][0]), "+v"(acc[ai][1][m][1]));
                    bp += 16 * D; OPQ(bp);
                    if (m & 1) asm volatile("" ::: "memory");
                }
                bp += 64 * D; OPQ(bp);
            }
        }
        st2.run(acc, u, wr, wc, fr, fq, lds, wid, lane);
        {
            f32x4 gv[2][2];
#pragma unroll
            for (int bj = 0; bj < 2; ++bj)
#pragma unroll
                for (int n = 0; n < 2; ++n) gv[bj][n] = *(const f32x4*)(g2 + col0 + bj * 128 + n * 4);
            bf16_t* op = x1b + (size_t)(u.pm * 256 + wr * 64 + fr) * D + col0; bf16_t* xp = xn + (size_t)(u.pm * 256 + wr * 64 + fr) * D + col0;
#pragma unroll
            for (int ai = 0; ai < 2; ++ai) {
#pragma unroll
                for (int m = 0; m < 4; ++m) {
                    const float r2 = Sg[ai * 128 + wr * 64 + m * 16 + fr];
#pragma unroll
                    for (int bj = 0; bj < 2; ++bj) { u32x4 wx, wv;
#pragma unroll
                        for (int n = 0; n < 2; ++n) { const f32x4 x1 = acc[ai][bj][m][n]; wx[2 * n] = pk2(x1[0], x1[1]); wx[2 * n + 1] = pk2(x1[2], x1[3]);
                            const f32x4 o = x1 * r2 * gv[bj][n]; wv[2 * n] = pk2(o[0], o[1]); wv[2 * n + 1] = pk2(o[2], o[3]); }
                        *(u32x4*)(op + bj * 128) = wx; *(u32x4*)(xp + bj * 128) = wv; }
                    op += 16 * D; xp += 16 * D; OPQ(op); OPQ(xp);
                }
                op += 64 * D; xp += 64 * D; OPQ(op); OPQ(xp);
            }
        }
    }
};
struct EpiRmsRes {
    static constexpr bool PERM = true, AFTER_DRAIN = true, HAS_MID = false;
    const bf16_t* x1b; float* out; const float* g1; RowStats st;
    __device__ __forceinline__ void fused(f32x4 (&acc)[2][2][4][2], const pg8::Unit& u, int wr, int wc, int fr, int fq, LAS unsigned char* lds, int wid, int lane) const {
        const LAS float* Sg = (const LAS float*)(lds + 8192);
        const int col0 = u.pn * 256 + wc * 32 + 8 * fq;
        const bf16_t* bp = x1b + (size_t)(u.pm * 256 + wr * 64 + fr) * D + col0; float* op = out + (size_t)(u.pm * 256 + wr * 64 + fr) * D + col0;
        u32x4 pre[2][4][2];
#pragma unroll
        for (int ai = 0; ai < 2; ++ai)
#pragma unroll
            for (int m = 0; m < 4; ++m)
#pragma unroll
                for (int bj = 0; bj < 2; ++bj) pre[ai][m][bj] = __builtin_nontemporal_load((const u32x4*)(bp + (size_t)(ai * 128 + m * 16) * D + bj * 128));
        st.run(acc, u, wr, wc, fr, fq, lds, wid, lane);
        f32x4 gv[2][2];
#pragma unroll
        for (int bj = 0; bj < 2; ++bj)
#pragma unroll
            for (int n = 0; n < 2; ++n) gv[bj][n] = *(const f32x4*)(g1 + col0 + bj * 128 + n * 4);
#pragma unroll
        for (int ai = 0; ai < 2; ++ai) {
#pragma unroll
            for (int m = 0; m < 4; ++m) {
                const float r1 = Sg[ai * 128 + wr * 64 + m * 16 + fr];
#pragma unroll
                for (int bj = 0; bj < 2; ++bj)
#pragma unroll
                    for (int n = 0; n < 2; ++n) { const unsigned px = pre[ai][m][bj][2 * n], py = pre[ai][m][bj][2 * n + 1]; f32x4 bs; bs[0] = bf2f(px & 0xffffu); bs[1] = bf2f(px >> 16); bs[2] = bf2f(py & 0xffffu); bs[3] = bf2f(py >> 16);
                        *(f32x4*)(op + bj * 128 + n * 4) = bs + acc[ai][bj][m][n] * r1 * gv[bj][n]; }
                op += 16 * D; OPQ(op);
            }
            op += 64 * D; OPQ(op);
        }
    }
};

template <int MAP> __device__ __forceinline__ int src_col(int s) {
    if (MAP == 1) s = in_tile(s >> 8) * 256 + (s & 255);
    if (MAP == 1) { if (s < 1536) { const int bj = (s >> 7) & 1, wc = (s >> 5) & 3, rest = s & 31; return (s & ~255) + 64 * wc + 32 * bj + rest; }
                    if (s >= 2560) { const int tg = (s - 2560) >> 8, bj = (s >> 7) & 1, cc = s & 127; return 2560 + bj * 1024 + 128 * tg + cc; } return s; }
    if (MAP == 2) { const int pn = s >> 8, bj = (s >> 7) & 1, cc = s & 127; return bj * FFH + 128 * pn + cc; }
    return s;
}
template <int MAP> __device__ __forceinline__ void transpose_item(const float* W, int K, int N, bf16_t* WT, LAS float* scr, int item, int lane, int ldk = 0) {
    const int nblk = N / 32, kb = item / nblk, nb = item % nblk, k0 = 64 * kb, n0 = 32 * nb;
    const int sc = src_col<MAP>(n0 + (lane & 31));
    float tv[32];
#pragma unroll
    for (int i = 0; i < 32; ++i) tv[i] = __builtin_nontemporal_load(W + (size_t)(k0 + 2 * i + (lane >> 5)) * N + sc);
#pragma unroll
    for (int i = 0; i < 32; ++i) scr[(2 * i + (lane >> 5)) * 33 + (lane & 31)] = tv[i];
    asm volatile("s_waitcnt lgkmcnt(0)" ::: "memory");
    const int c = lane & 7;
#pragma unroll
    for (int j = 0; j < 4; ++j) { const int n = (lane >> 3) + 8 * j; const LAS float* s = scr + (8 * c) * 33 + n;
        u32x4 o; o.x = pk2(s[0 * 33], s[1 * 33]); o.y = pk2(s[2 * 33], s[3 * 33]); o.z = pk2(s[4 * 33], s[5 * 33]); o.w = pk2(s[6 * 33], s[7 * 33]);
        *(u32x4*)(WT + (size_t)(n0 + n) * (ldk ? ldk : K) + k0 + 8 * c) = o; }
    asm volatile("s_waitcnt lgkmcnt(0)" ::: "memory");
}

template <int MAP> __device__ __forceinline__ void transpose_sub(const float* W, int K, int N, bf16_t* WT, LAS float* scr, int item, int sub, int lane) {
    const int nblk = N / 32, kb = item / nblk, nb = item % nblk, k0 = 64 * kb + 8 * sub, n0 = 32 * nb;
    const int sc = src_col<MAP>(n0 + (lane & 31));
    float tv[4];
#pragma unroll
    for (int i = 0; i < 4; ++i) tv[i] = __builtin_nontemporal_load(W + (size_t)(k0 + 2 * i + (lane >> 5)) * N + sc);
#pragma unroll
    for (int i = 0; i < 4; ++i) scr[(2 * i + (lane >> 5)) * 33 + (lane & 31)] = tv[i];
    asm volatile("s_waitcnt lgkmcnt(0)" ::: "memory");
    if (lane < 32) { const LAS float* sp = scr + lane;
        u32x4 o; o.x = pk2(sp[0 * 33], sp[1 * 33]); o.y = pk2(sp[2 * 33], sp[3 * 33]); o.z = pk2(sp[4 * 33], sp[5 * 33]); o.w = pk2(sp[6 * 33], sp[7 * 33]);
        *(u32x4*)(WT + (size_t)(n0 + lane) * K + k0) = o; }
    asm volatile("s_waitcnt lgkmcnt(0)" ::: "memory");
}

template <int W> __device__ __forceinline__ void pool_unit(const bf16_t* Ub, const bf16_t* WmT, const float* pool_scale, bf16_t* YP, int tt, int g, int c, int q) {
    const int t = 16 * tt + c;
    const int cnt = (t + 1 < W) ? t + 1 : W; const float rc = 1.0f / (float)cnt;
    bf16x8 zf[2];
#pragma unroll
    for (int kc = 0; kc < 2; ++kc) {
        const bf16_t* up = Ub + (size_t)t * 256 + g * 64 + 32 * kc + 8 * q;
        u32x4 v[W];
#pragma unroll
        for (int i = 0; i < W; ++i) { const int ti = (i <= t) ? i : 0; v[i] = *(const u32x4*)(up - (size_t)ti * 256); }
        float sum[8];
#pragma unroll
        for (int e = 0; e < 8; ++e) sum[e] = 0.f;
#pragma unroll
        for (int i = 0; i < W; ++i) { const float wgt = (i <= t) ? 1.0f : 0.0f;
#pragma unroll
            for (int e = 0; e < 4; ++e) { sum[2 * e] += wgt * bf2f(v[i][e] & 0xffffu); sum[2 * e + 1] += wgt * bf2f(v[i][e] >> 16); } }
        u32x4 zw;
#pragma unroll
        for (int e = 0; e < 4; ++e) zw[e] = pk2(sum[2 * e] * rc - bf2f(v[0][e] & 0xffffu), sum[2 * e + 1] * rc - bf2f(v[0][e] >> 16));
        zf[kc] = __builtin_bit_cast(bf16x8, zw);
    }
#pragma unroll
    for (int dt = 0; dt < 4; ++dt) {
        const bf16_t* wp = WmT + (size_t)g * 4096 + (16 * dt + c) * 64 + 8 * q;
        const bf16x8 a0 = *(const bf16x8*)wp, a1 = *(const bf16x8*)(wp + 32);
        f32x4 a = (f32x4){0.f, 0.f, 0.f, 0.f};
        a = __builtin_amdgcn_mfma_f32_16x16x32_bf16(a0, zf[0], a, 0, 0, 0);
        a = __builtin_amdgcn_mfma_f32_16x16x32_bf16(a1, zf[1], a, 0, 0, 0);
        const f32x4 scl = *(const f32x4*)(pool_scale + g * 64 + 16 * dt + 4 * q);
        u32x2 wv; wv.x = pk2(a[0] * scl[0], a[1] * scl[1]); wv.y = pk2(a[2] * scl[2], a[3] * scl[3]);
        *(u32x2*)(YP + (size_t)t * 512 + 256 + g * 64 + 16 * dt + 4 * q) = wv;
    }
}

#define XB_TMO      128
#define XB_XCNT(j)  (256  + 64 * (j))
#define XB_XSUB(j)  (1280 + 64 * (j))
#define XB_XGEN(j)  (2304 + 64 * (j))
#define XB_TOP      3328
#define XB_TOPGEN   3392
#define XCD_BAR_WORDS 3456
#define XB_SPIN_CAP (1u << 18)

__device__ __forceinline__ unsigned xb_ld(unsigned* p)              { return __hip_atomic_load(p, __ATOMIC_RELAXED, __HIP_MEMORY_SCOPE_AGENT); }
__device__ __forceinline__ unsigned xb_add(unsigned* p, unsigned v) { return __hip_atomic_fetch_add(p, v, __ATOMIC_RELAXED, __HIP_MEMORY_SCOPE_AGENT); }
__device__ __forceinline__ unsigned xb_xcc_id() { return (unsigned)__builtin_amdgcn_s_getreg((3 << 11) | 20) & 0xFu; }
#define XB_SPIN(cond, bar) do { unsigned _sp = 0; while (cond) { __builtin_amdgcn_s_sleep(1); \
    if ((++_sp & 255u) == 0u) { if (xb_ld(&(bar)[XB_TMO])) break; if (_sp > XB_SPIN_CAP) { atomicAdd(&(bar)[XB_TMO], 1u); break; } } } } while (0)

struct XcdBarrier {
    unsigned* bar; unsigned x;
    volatile LAS unsigned* st;
};

__device__ __forceinline__ XcdBarrier xcd_barrier_post(unsigned* bar, volatile LAS unsigned* st) {
    XcdBarrier b; b.bar = bar; b.x = xb_xcc_id(); b.st = st;
    if (threadIdx.x == 0) (void)xb_add(&bar[XB_XCNT(b.x)], 1u);
    return b;
}
__device__ __forceinline__ void xcd_barrier_complete(unsigned* bar, unsigned x, unsigned& nloc, unsigned& nx) {
    const unsigned G = gridDim.x * gridDim.y * gridDim.z;
    unsigned sum, cnt, mine, sp = 0u;
    for (;;) {
        sum = 0u; cnt = 0u; mine = 0u;
#pragma unroll
        for (unsigned j = 0; j < 16; ++j) { const unsigned c = xb_ld(&bar[XB_XCNT(j)]); sum += c; cnt += (c > 0u) ? 1u : 0u; mine = (j == x) ? c : mine; }
        if (sum == G) break;
        __builtin_amdgcn_s_sleep(1);
        if ((++sp & 255u) == 0u) { if (xb_ld(&bar[XB_TMO])) break; if (sp > XB_SPIN_CAP) { atomicAdd(&bar[XB_TMO], 1u); break; } }
    }
    nloc = mine > 0u ? mine : 1u; nx = cnt > 0u ? cnt : 1u;
}

__device__ __forceinline__ void xcd_barrier(const XcdBarrier& b) {
    asm volatile("s_waitcnt vmcnt(0)" ::: "memory");
    __syncthreads();
    if (threadIdx.x == 0) {
        unsigned* bar = b.bar;
        __builtin_amdgcn_s_waitcnt(0);
        unsigned nloc = b.st[0], nx = b.st[1];
        if (nloc == 0u) { xcd_barrier_complete(bar, b.x, nloc, nx); b.st[0] = nloc; b.st[1] = nx; }
        const unsigned old = xb_add(&bar[XB_XSUB(b.x)], 1u);
        const unsigned gen = old / nloc;
        if (old + 1u == (gen + 1u) * nloc) {
            __builtin_amdgcn_fence(__ATOMIC_RELEASE, "agent");
            asm volatile("s_waitcnt vmcnt(0)" ::: "memory");
            const unsigned og = xb_add(&bar[XB_TOP], 1u);
            const unsigned tg = og / nx;
            if (og + 1u == (tg + 1u) * nx) xb_add(&bar[XB_TOPGEN], 1u);
            else XB_SPIN(xb_ld(&bar[XB_TOPGEN]) == tg, bar);
            __builtin_amdgcn_fence(__ATOMIC_ACQUIRE, "agent");
            xb_add(&bar[XB_XGEN(b.x)], 1u);
            asm volatile("s_waitcnt vmcnt(0)" ::: "memory");
        } else {
            XB_SPIN(xb_ld(&bar[XB_XGEN(b.x)]) == gen, bar);
            __builtin_amdgcn_fence(__ATOMIC_ACQUIRE, "agent");
            asm volatile("s_waitcnt vmcnt(0)" ::: "memory");
        }
    }
    __syncthreads();
}


struct Args { const float* in[13]; float* out; unsigned char* ws; float invf[32]; int lo, hi; };

__global__ void __launch_bounds__(512, 2) fwd_mega(Args args) {
    extern __shared__ __attribute__((aligned(16))) unsigned char lds_raw[];
    LAS unsigned char* lds = (LAS unsigned char*)lds_raw;
    cg::grid_group grid = cg::this_grid();
    const int wave = __builtin_amdgcn_readfirstlane((int)threadIdx.x >> 6);
#define LANE_TID() const int lane = lane_id_asm(), tid = wave * 64 + lane
    const int G = gridDim.x, gw = blockIdx.x * 8 + wave, NGW = G * 8;
    const int lo = args.lo, hi = args.hi;
    volatile LAS unsigned* MISC = (volatile LAS unsigned*)(lds + 131072);
    if (threadIdx.x < 2) MISC[threadIdx.x] = 0u;
    __syncthreads();
    if (hi > NPHASE + 1) grid.sync();
    const XcdBarrier xbar = xcd_barrier_post((unsigned*)(args.ws + WS_CTL) + CW_XBAR, MISC);
#define IN(k) (lo <= (k) && (k) < hi)
#define WSP(T, off) ((T*)(args.ws + (off)))
#define SEAM(k) do { if (IN(k) && IN((k) + 1)) xcd_barrier(xbar); } while (0)

    for (int rep_ = 0; rep_ < NREP(0); ++rep_) { if (rep_) xcd_barrier(xbar);
    if (IN(0)) {
        LANE_TID(); (void)tid;
        LAS float* scr = (LAS float*)(lds + wave * 16384);
        const float* x = args.in[0]; const float* g_pre_mix = args.in[1]; const float* w_in = args.in[2];
        bf16_t* WinT = WSP(bf16_t, WS_WIN); float* tab = WSP(float, WS_TAB); bf16_t* Hb = WSP(bf16_t, WS_H);
        constexpr int I_IN = (D / 64) * (NIN / 32);
        {
            const int nfull = (I_IN / NGW) * NGW;
            for (int it = gw; it < nfull; it += NGW) transpose_item<1>(w_in, D, NIN, WinT, scr, it, lane);
            for (int it = nfull + (int)blockIdx.x; it < I_IN; it += G) transpose_sub<1>(w_in, D, NIN, WinT, scr, it, wave, lane);
        }
        for (int e = blockIdx.x * 512 + tid; e < S * 32; e += G * 512) {
            const int pos = e >> 5, f = e & 31;
            const float ang = (float)pos * args.invf[f];
            const double rev = (double)ang * 0.15915494309189535;
            const float fr = (float)(rev - floor(rev));
            tab[2 * e] = __builtin_amdgcn_cosf(fr); tab[2 * e + 1] = __builtin_amdgcn_sinf(fr);
        }
        {
            f32x4 gq[4];
#pragma unroll
            for (int j = 0; j < 4; ++j) gq[j] = ((const f32x4*)g_pre_mix)[lane + 64 * j];
            for (int m = gw; m < S; m += 2 * NGW) {
                const int m2 = m + NGW;
                const f32x4* xa = (const f32x4*)(x + (size_t)m * D) + lane; const f32x4* xb = (const f32x4*)(x + (size_t)(m2 < S ? m2 : m) * D) + lane;
                f32x4 va[4], vb[4]; float sa = 0.f, sb = 0.f;
#pragma unroll
                for (int j = 0; j < 4; ++j) { va[j] = __builtin_nontemporal_load(xa + 64 * j); vb[j] = __builtin_nontemporal_load(xb + 64 * j); }
#pragma unroll
                for (int j = 0; j < 4; ++j) { sa += (va[j][0] * va[j][0] + va[j][1] * va[j][1]) + (va[j][2] * va[j][2] + va[j][3] * va[j][3]); sb += (vb[j][0] * vb[j][0] + vb[j][1] * vb[j][1]) + (vb[j][2] * vb[j][2] + vb[j][3] * vb[j][3]); }
                const float ra = 1.0f / sqrtf(wave_sum(sa) * (1.0f / D) + EPS), rb = 1.0f / sqrtf(wave_sum(sb) * (1.0f / D) + EPS);
                u32x2* oa = (u32x2*)(Hb + (size_t)m * D) + lane; u32x2* ob = (u32x2*)(Hb + (size_t)m2 * D) + lane;
#pragma unroll
                for (int j = 0; j < 4; ++j) { u32x2 w; w.x = pk2(va[j][0] * ra * gq[j][0], va[j][1] * ra * gq[j][1]); w.y = pk2(va[j][2] * ra * gq[j][2], va[j][3] * ra * gq[j][3]); oa[64 * j] = w; }
                if (m2 < S) {
#pragma unroll
                    for (int j = 0; j < 4; ++j) { u32x2 w; w.x = pk2(vb[j][0] * rb * gq[j][0], vb[j][1] * rb * gq[j][1]); w.y = pk2(vb[j][2] * rb * gq[j][2], vb[j][3] * rb * gq[j][3]); ob[64 * j] = w; }
                }
            }
        }
    } }
    SEAM(0);

    for (int rep_ = 0; rep_ < NREP(1); ++rep_) { if (rep_) xcd_barrier(xbar);
    if (IN(1)) {
        LANE_TID(); (void)tid;
        pg8::Gemm g{WSP(bf16_t, WS_H), WSP(bf16_t, WS_WIN), S, NIN, D}; pg8::StaticOrder So; So.init(S, NIN, G, (int)blockIdx.x);
        EpiIn E{WSP(bf16_t, WS_QKV), WSP(bf16_t, WS_U), WSP(bf16_t, WS_GATES), WSP(float, WS_TAB)};
        pg8::gemm_phase<EpiIn, pg8::StaticOrder, true, true>(lds, g, So, E, wave, lane);
        {
            const int nwg = (S / 256) * (NIN / 256), rem = nwg % G;
            const bool helper = (rem == 0) || ((int)blockIdx.x >= rem);
            if (helper) {
                const int nh = (rem == 0) ? G : G - rem, hid = (rem == 0) ? (int)blockIdx.x : (int)blockIdx.x - rem;
                const float* w_mix = args.in[3]; const float* w_pa = args.in[5]; const float* w_pp = args.in[6]; const float* w_out = args.in[7]; const float* w_gu = args.in[10]; const float* w_down = args.in[11];
                bf16_t* WpaT = WSP(bf16_t, WS_WPA); bf16_t* WoutT = WSP(bf16_t, WS_WOUT); bf16_t* WguT = WSP(bf16_t, WS_WGU); bf16_t* WdT = WSP(bf16_t, WS_WD); bf16_t* WmT = WSP(bf16_t, WS_WMT);
                LAS float* scr = (LAS float*)(lds + wave * 16384);
                constexpr int I_PA = (256 / 64) * (D / 32), I_OUT = (D / 64) * (D / 32), I_GU = (D / 64) * (NGU / 32), I_DN = (FFH / 64) * (D / 32), I_MX = 4 * 2;
                constexpr int NDEF = 2 * I_PA + I_OUT + I_GU + I_DN + I_MX;
                for (int it = hid * 8 + wave; it < NDEF; it += nh * 8) {
                    int r = it;
                    if (r < I_MX) { const int gg = r >> 1; transpose_item<0>(w_mix + gg * 4096, 64, 64, WmT + gg * 4096, scr, r & 1, lane); continue; } r -= I_MX;
                    if (r < I_PA) { transpose_item<0>(w_pa, 256, D, WpaT, scr, r, lane, 512); continue; } r -= I_PA;
                    if (r < I_PA) { transpose_item<0>(w_pp, 256, D, WpaT + 256, scr, r, lane, 512); continue; } r -= I_PA;
                    if (r < I_OUT) { transpose_item<0>(w_out, D, D, WoutT, scr, r, lane); continue; } r -= I_OUT;
                    if (r < I_GU) { transpose_item<2>(w_gu, D, NGU, WguT, scr, r, lane); continue; } r -= I_GU;
                    transpose_item<0>(w_down, FFH, D, WdT, scr, r, lane);
                }
            }
        }
    } }
    SEAM(1);

    for (int rep_ = 0; rep_ < NREP(2); ++rep_) { if (rep_) xcd_barrier(xbar);
    if (IN(2)) {
        LANE_TID(); (void)tid;
        constexpr int RS = 192, NU = NHEAD * 128;
        const bf16_t* QKV = WSP(bf16_t, WS_QKV); const bf16_t* Ub = WSP(bf16_t, WS_U); bf16_t* OG = WSP(bf16_t, WS_OG); float* LSE = WSP(float, WS_LSE); bf16_t* YP = WSP(bf16_t, WS_OA);
        const bf16_t* WmT = WSP(bf16_t, WS_WMT); const float* pool_scale = args.in[4];
        LAS unsigned char* Kl = lds; LAS unsigned char* Vl = lds + 272 * RS;
        const int c = lane & 15, q = lane >> 4;
        const int rq = tid >> 3, ch = tid & 7, chs = ch ^ ((rq >> 2) & 3);
        for (int i = tid; i < 2 * 768; i += 512) { LAS unsigned char* base = (i < 768) ? Kl : Vl; const int j = (i < 768) ? i : i - 768; *(LAS unsigned*)(base + 256 * RS + 4 * j) = 0u; }
#define AU_OF(un_, h_, row0_, sh_, first_) const int h_ = (un_) >> 7, row0_ = ((un_) & 127) * 128, sh_ = 2 * (h_ >> 2); const bool first_ = (row0_ & ((S >> sh_) - 1)) == 0
#define KV_LOAD(kv, h_, row0_, first_) do { const bf16_t* pk_ = QKV + ((size_t)(NHEAD + (h_)) * S + ((row0_) - 128 + rq)) * HD + 8 * ch; const bf16_t* pv_ = QKV + ((size_t)(2 * NHEAD + (h_)) * S + ((row0_) - 128 + rq)) * HD + 8 * ch; \
            _Pragma("unroll") for (int i_ = 0; i_ < 4; ++i_) { if (i_ >= 2 || !(first_)) { kv[i_] = *(const u32x4*)(pk_ + (size_t)i_ * 64 * HD); kv[4 + i_] = *(const u32x4*)(pv_ + (size_t)i_ * 64 * HD); } \
                else { kv[i_] = (u32x4){0u, 0u, 0u, 0u}; kv[4 + i_] = (u32x4){0u, 0u, 0u, 0u}; } } } while (0)
#define KV_WRITE(kv) do { _Pragma("unroll") for (int i_ = 0; i_ < 4; ++i_) { *(LAS u32x4*)(Kl + (64 * i_ + rq) * RS + chs * 16) = kv[i_]; *(LAS u32x4*)(Vl + (64 * i_ + rq) * RS + chs * 16) = kv[4 + i_]; } } while (0)
#define Q_LOAD(qf, h_, row0_) do { const bf16_t* Qp_ = QKV + ((size_t)(h_) * S + ((row0_) + 16 * wave + c)) * HD + 8 * q; qf[0] = __builtin_nontemporal_load((const bf16x8*)Qp_); qf[1] = __builtin_nontemporal_load((const bf16x8*)(Qp_ + 32)); } while (0)
        typedef short s16x4 __attribute__((ext_vector_type(4)));
        u32x4 kv[8]; bf16x8 qf[2], qn[2];
        int un = blockIdx.x;
        if (un < NU) { AU_OF(un, h0, r0, s0, f0); (void)s0; KV_LOAD(kv, h0, r0, f0); Q_LOAD(qf, h0, r0); }
        for (; un < NU; un += G) {
            AU_OF(un, h, row0, sh, first);
            const int un2 = un + G; const bool has2 = un2 < NU;
            AU_OF((has2 ? un2 : un), h2, row2, sh2, first2); (void)sh2;
            __syncthreads();
            KV_WRITE(kv);
            __syncthreads();
            if (has2) { KV_LOAD(kv, h2, row2, first2); Q_LOAD(qn, h2, row2); }
            const int L = S >> sh;
            {
                const int qrow = row0 + 16 * wave + c;
                f32x4 sc[10];
#pragma unroll
                for (int t = 0; t < 10; ++t) {
                    const int krow = 16 * wave + 32 * (t >> 1) + 8 * (c >> 2) + 4 * (t & 1) + (c & 3);
                    const int kx = (q ^ ((2 * (c >> 2) + (t & 1)) & 3)) * 16;
                    const bf16x8 k0 = *(const LAS bf16x8*)(Kl + krow * RS + kx), k1 = *(const LAS bf16x8*)(Kl + krow * RS + 64 + kx);
                    f32x4 a = (f32x4){0.f, 0.f, 0.f, 0.f};
                    a = __builtin_amdgcn_mfma_f32_16x16x32_bf16(k0, qf[0], a, 0, 0, 0);
                    a = __builtin_amdgcn_mfma_f32_16x16x32_bf16(k1, qf[1], a, 0, 0, 0);
                    sc[t] = a;
                }
                const int ql = 128 + 16 * wave + c;
                float mx = -1e30f;
#pragma unroll
                for (int t = 0; t < 10; ++t)
#pragma unroll
                    for (int rg = 0; rg < 4; ++rg) {
                        const int kl = 16 * wave + 32 * (t >> 1) + 8 * q + 4 * (t & 1) + rg, dist = ql - kl;
                        const bool valid = dist >= 0 && dist <= 128 && (kl >= 128 || !first);
                        const float sv = valid ? sc[t][rg] * 0.18033688011112042f : -1e30f;
                        sc[t][rg] = sv; mx = fmaxf(mx, sv);
                    }
                mx = fmaxf(mx, __shfl_xor(mx, 16)); mx = fmaxf(mx, __shfl_xor(mx, 32));
                float lsum = 0.f;
#pragma unroll
                for (int t = 0; t < 10; ++t)
#pragma unroll
                    for (int rg = 0; rg < 4; ++rg) { const float pv = __builtin_amdgcn_exp2f(sc[t][rg] - mx); sc[t][rg] = pv; lsum += pv; }
                lsum += __shfl_xor(lsum, 16); lsum += __shfl_xor(lsum, 32);
                f32x4 o[4];
#pragma unroll
                for (int dt = 0; dt < 4; ++dt) o[dt] = (f32x4){0.f, 0.f, 0.f, 0.f};
#pragma unroll
                for (int cc = 0; cc < 5; ++cc) {
                    u32x4 pw; pw.x = pk2(sc[2 * cc][0], sc[2 * cc][1]); pw.y = pk2(sc[2 * cc][2], sc[2 * cc][3]); pw.z = pk2(sc[2 * cc + 1][0], sc[2 * cc + 1][1]); pw.w = pk2(sc[2 * cc + 1][2], sc[2 * cc + 1][3]);
                    const bf16x8 pf = __builtin_bit_cast(bf16x8, pw);
                    LAS unsigned char* vb = Vl + (16 * wave + 32 * cc + 8 * q + (c >> 2)) * RS + 8 * (c & 1);
                    const int px = (c >> 1) & 1, x0 = (2 * q) & 3, x1 = (2 * q + 1) & 3;
#pragma unroll
                    for (int dt = 0; dt < 4; ++dt) {
                        const s16x4 v0 = __builtin_bit_cast(s16x4, __builtin_amdgcn_ds_read_tr16_b64_v4i16((LAS s16x4*)(vb + 16 * ((2 * dt + px) ^ x0))));
                        const s16x4 v1 = __builtin_bit_cast(s16x4, __builtin_amdgcn_ds_read_tr16_b64_v4i16((LAS s16x4*)(vb + 4 * RS + 16 * ((2 * dt + px) ^ x1))));
                        bf16x8 vf; vf[0] = v0[0]; vf[1] = v0[1]; vf[2] = v0[2]; vf[3] = v0[3]; vf[4] = v1[0]; vf[5] = v1[1]; vf[6] = v1[2]; vf[7] = v1[3];
                        o[dt] = __builtin_amdgcn_mfma_f32_16x16x32_bf16(vf, pf, o[dt], 0, 0, 0);
                    }
                }
                const float inv = 1.0f / lsum;
                const int tok = ((qrow & (L - 1)) << sh) + (qrow >> (14 - sh));
                bf16_t* op = OG + ((size_t)h * S + tok) * HD + 4 * q;
#pragma unroll
                for (int dt = 0; dt < 4; ++dt) { u32x2 w; w.x = pk2(o[dt][0] * inv, o[dt][1] * inv); w.y = pk2(o[dt][2] * inv, o[dt][3] * inv); *(u32x2*)(op + 16 * dt) = w; }
                if (q == 0) LSE[(size_t)h * S + tok] = (mx + __log2f(lsum)) * 0.6931471805599453f;
            }
            qf[0] = qn[0]; qf[1] = qn[1];
        }
#undef AU_OF
#undef KV_LOAD
#undef KV_WRITE
#undef Q_LOAD
        for (int wu = gw; wu < (S / 16) * 4; wu += NGW) {
            const int tt = wu >> 2, g = wu & 3;
            if (g == 0) pool_unit<2>(Ub, WmT, pool_scale, YP, tt, 0, c, q);
            else if (g == 1) pool_unit<4>(Ub, WmT, pool_scale, YP, tt, 1, c, q);
            else if (g == 2) pool_unit<8>(Ub, WmT, pool_scale, YP, tt, 2, c, q);
            else pool_unit<16>(Ub, WmT, pool_scale, YP, tt, 3, c, q);
        }
    } }
    SEAM(2);

    for (int rep_ = 0; rep_ < NREP(3); ++rep_) { if (rep_) xcd_barrier(xbar);
    if (IN(3)) {
        LANE_TID(); (void)tid;
        const bf16_t* OG = WSP(bf16_t, WS_OG); const float* LSE = WSP(float, WS_LSE); bf16_t* OA = WSP(bf16_t, WS_OA);
        for (int e0 = blockIdx.x * 512 + tid; e0 < S * 32; e0 += 4 * G * 512) {
            float l0[4], l1[4], l2[4]; u32x4 v0[4], v1[4], v2[4];
#pragma unroll
            for (int k = 0; k < 4; ++k) {
                const int e = e0 + k * G * 512, ec = e < S * 32 ? e : e0;
                const int d8 = ec & 7, j = (ec >> 3) & 3, t = ec >> 5;
                l0[k] = LSE[(size_t)(0 + j) * S + t]; l1[k] = LSE[(size_t)(4 + j) * S + t]; l2[k] = LSE[(size_t)(8 + j) * S + t];
                v0[k] = __builtin_nontemporal_load((const u32x4*)(OG + ((size_t)(0 + j) * S + t) * HD + 8 * d8)); v1[k] = __builtin_nontemporal_load((const u32x4*)(OG + ((size_t)(4 + j) * S + t) * HD + 8 * d8)); v2[k] = __builtin_nontemporal_load((const u32x4*)(OG + ((size_t)(8 + j) * S + t) * HD + 8 * d8));
            }
#pragma unroll
            for (int k = 0; k < 4; ++k) {
                const int e = e0 + k * G * 512;
                if (e < S * 32) {
                    const int d8 = e & 7, j = (e >> 3) & 3, t = e >> 5;
                    const float mx = fmaxf(l0[k], fmaxf(l1[k], l2[k]));
                    float w0 = __expf(l0[k] - mx), w1 = __expf(l1[k] - mx), w2 = __expf(l2[k] - mx);
                    const float inv = __builtin_amdgcn_rcpf(w0 + w1 + w2); w0 *= inv; w1 *= inv; w2 *= inv;
                    u32x4 o;
#pragma unroll
                    for (int i = 0; i < 4; ++i) {
                        const float a = w0 * bf2f(v0[k][i] & 0xffffu) + w1 * bf2f(v1[k][i] & 0xffffu) + w2 * bf2f(v2[k][i] & 0xffffu);
                        const float bb = w0 * bf2f(v0[k][i] >> 16) + w1 * bf2f(v1[k][i] >> 16) + w2 * bf2f(v2[k][i] >> 16);
                        o[i] = pk2(a, bb);
                    }
                    *(u32x4*)(OA + (size_t)t * 512 + 64 * j + 8 * d8) = o;
                }
            }
        }
    } }
    SEAM(3);

    for (int rep_ = 0; rep_ < NREP(4); ++rep_) { if (rep_) xcd_barrier(xbar);
    if (IN(4)) {
        LANE_TID(); (void)tid;
        int K1 = 512; asm volatile("" : "+s"(K1));
        pg8::Gemm g{WSP(bf16_t, WS_OA), WSP(bf16_t, WS_WPA), S, D, K1}; pg8::StaticOrder So; So.init(S, D, G, (int)blockIdx.x);
        EpiGate2 E{WSP(bf16_t, WS_GATES), WSP(bf16_t, WS_H)};
        pg8::gemm_phase<EpiGate2, pg8::StaticOrder, true, true>(lds, g, So, E, wave, lane);
    } }
    SEAM(4);

    { const int rep_ = 0; (void)rep_;
    if (IN(5)) {
        LANE_TID(); (void)tid;
        pg8::Gemm g{WSP(bf16_t, WS_H), WSP(bf16_t, WS_WOUT), S, D, D}; pg8::StaticOrder So; So.init(S, D, G, (int)blockIdx.x);
        RowStats st1{WSP(unsigned, WS_XBUF + (size_t)rep_ * 786432), WSP(unsigned, WS_CTL) + (rep_ ? 20480 : 1024)}; RowStats st2{WSP(unsigned, WS_XBUF + 262144 + (size_t)rep_ * 786432), WSP(unsigned, WS_CTL) + (rep_ ? 20480 : 1024) + 4096};
        EpiRmsResRms E{args.in[0], WSP(bf16_t, WS_X1), WSP(bf16_t, WS_H2), args.in[8], args.in[9], st1, st2};
        pg8::gemm_phase<EpiRmsResRms, pg8::StaticOrder, false, true>(lds, g, So, E, wave, lane);
    } }
    SEAM(5);

    for (int rep_ = 0; rep_ < NREP(7); ++rep_) { if (rep_) xcd_barrier(xbar);
    if (IN(7)) {
        LANE_TID(); (void)tid;
        pg8::Gemm g{WSP(bf16_t, WS_H2), WSP(bf16_t, WS_WGU), S, NGU, D}; pg8::StaticOrder So; So.init(S, NGU, G, (int)blockIdx.x);
        EpiSwiglu E{WSP(bf16_t, WS_ACT)};
        pg8::gemm_phase<EpiSwiglu, pg8::StaticOrder, true, true>(lds, g, So, E, wave, lane);
    } }
    SEAM(7);

    { const int rep_ = 0; (void)rep_;
    if (IN(8)) {
        LANE_TID(); (void)tid;
        pg8::Gemm g{WSP(bf16_t, WS_ACT), WSP(bf16_t, WS_WD), S, D, FFH}; pg8::StaticOrder So; So.init(S, D, G, (int)blockIdx.x);
        RowStats st{WSP(unsigned, WS_XBUF + 2 * 262144 + (size_t)rep_ * 786432), WSP(unsigned, WS_CTL) + (rep_ ? 20480 : 1024) + 2 * 4096};
        EpiRmsRes E{WSP(bf16_t, WS_X1), args.out, args.in[12], st};
        pg8::gemm_phase<EpiRmsRes, pg8::StaticOrder, false, true>(lds, g, So, E, wave, lane);
    } }
#undef IN
#undef LANE_TID
#undef WSP
#undef SEAM
}

extern "C" void kernel_launch(void* const* d_in, const int* in_sizes, int n_in, void* d_out, int out_size, void* d_ws, size_t ws_size, hipStream_t stream) {
    static int grid = 0;
    if (grid == 0) {
        if (n_in != 13 || in_sizes[0] != S * D || out_size != S * D || ws_size < WS_END) { fprintf(stderr, "kernel_launch: unexpected shapes (n_in %d, in0 %d, out %d, ws %zu)\n", n_in, n_in > 0 ? in_sizes[0] : -1, out_size, ws_size); grid = -1; return; }
        int dev = 0, cus = 0, per_cu = 0;
        (void)hipGetDevice(&dev);
        (void)hipDeviceGetAttribute(&cus, hipDeviceAttributeMultiprocessorCount, dev);
        if (hipFuncSetAttribute((const void*)fwd_mega, hipFuncAttributeMaxDynamicSharedMemorySize, LDS_BYTES) != hipSuccess) fprintf(stderr, "kernel_launch: hipFuncSetAttribute failed\n");
        if (hipOccupancyMaxActiveBlocksPerMultiprocessor(&per_cu, (const void*)fwd_mega, 512, LDS_BYTES) != hipSuccess || per_cu < 1) { fprintf(stderr, "kernel_launch: occupancy query says %d\n", per_cu); per_cu = 1; }
        (void)hipGetLastError();
        if (cus <= 0) cus = 256;
        grid = cus * per_cu;
    }
    if (grid < 0) return;
    Args a{};
    for (int i = 0; i < 13; ++i) a.in[i] = (const float*)d_in[i];
    a.out = (float*)d_out; a.ws = (unsigned char*)d_ws;
    for (int f = 0; f < 32; ++f) a.invf[f] = (float)pow(10000.0, -(double)f / 32.0);
    a.lo = 0; a.hi = NPHASE;
    (void)hipMemsetAsync((unsigned char*)d_ws + WS_CTL, 0, CTL_ZERO_BYTES, stream);
    void* kargs[] = {&a};
    hipError_t e = hipLaunchCooperativeKernel((const void*)fwd_mega, dim3(grid), dim3(512), kargs, LDS_BYTES, stream);
    if (e != hipSuccess) fprintf(stderr, "kernel_launch: cooperative launch failed: %s (grid %d)\n", hipGetErrorString(e), grid);
}
```

```cpp
#include <hip/hip_runtime.h>
#include <hip/hip_cooperative_groups.h>
#include <cstdio>
#include <cstdint>
#include <cmath>
namespace cg = cooperative_groups;
namespace pg8 {
#define PG8_LAS __attribute__((address_space(3)))
typedef unsigned short bf16_t;
typedef short bf16x8 __attribute__((ext_vector_type(8)));
typedef float f32x4 __attribute__((ext_vector_type(4)));
typedef unsigned u32x4 __attribute__((ext_vector_type(4)));
constexpr int BM = 256, BK = 64, HALF = 128, HTB = HALF * BK * 2  , STAGE_BYTES = 8 * HTB, NXCD = 8, WGM = 8;

__host__ __device__ __forceinline__ int lds_byte(int r, int c) { const int st = (r >> 4) * 2 + (c >> 5), rr = r & 15, cc = c & 31, ob = rr * 64 + cc * 2; return st * 1024 + (ob ^ (((ob >> 9) & 1) << 5)); }
__host__ __device__ __forceinline__ void stage_rc(int b, int& R, int& C) { const int st = b / 1024, sb = b % 1024, swz = sb ^ (((sb >> 9) & 1) << 5); R = (st >> 1) * 16 + swz / 64; C = (st & 1) * 32 + (swz % 64) / 2; }
__host__ __device__ __forceinline__ int perm32(int rho) { const int n = rho >> 4, i = rho & 15; return 8 * (i >> 2) + 4 * n + (i & 3); }

struct Unit { int pm, pn; };
struct Gemm { const bf16_t* A; const bf16_t* Bt; int M, N, K; };

struct StaticOrder {
    int nM, nN, nwg, G, c;
    __host__ __device__ void init(int M, int N, int G_, int c_) { nM = M / BM; nN = N / BM; nwg = nM * nN; G = G_; c = c_; }
    __host__ __device__ bool next(int i, Unit& u) const {
        const long L = (long)i * G + c; if (L >= nwg) return false;
        int wgid = (int)L; { const int q = nwg / NXCD, r = nwg % NXCD, xcd = wgid % NXCD, off = wgid / NXCD; wgid = (xcd < r ? xcd * (q + 1) : r * (q + 1) + (xcd - r) * q) + off; }
        const int nig = WGM * nN, gid = wgid / nig, fm = gid * WGM, gsz = (nM - fm) < WGM ? (nM - fm) : WGM;
        u.pm = fm + ((wgid % nig) % gsz); u.pn = (wgid % nig) / gsz; return true;
    }
    __device__ __forceinline__ void a_ready(const Unit&) const {}
    __device__ __forceinline__ void done(const Unit&) const {}
};
__device__ __forceinline__ unsigned cvt_pk_bf16(float lo, float hi) { unsigned r; asm volatile("v_cvt_pk_bf16_f32 %0, %1, %2" : "=v"(r) : "v"(lo), "v"(hi)); return r; }
typedef float f32x2 __attribute__((ext_vector_type(2)));
template <class Epi, class Sched, bool ALIGN_EPI = false, bool SP2 = false>
__device__ __forceinline__ void gemm_phase(PG8_LAS unsigned char* lds, const Gemm g, const Sched& S, const Epi& E, const int wid, const int lane) {
    const int tid = wid * 64 + lane, wr = wid >> 2, wc = wid & 3, fr = lane & 15, fq = lane >> 4;
    const int K = g.K, nt = K / BK;
    unsigned voffA[2], voffB[2];
#pragma unroll
    for (int i = 0; i < 2; ++i) { int R, C; stage_rc(tid * 16 + i * 8192, R, C); const int Rb = Epi::PERM ? ((R & ~31) + perm32(R & 31)) : R;
        voffA[i] = (unsigned)(R * K + C) * 2u; voffB[i] = (unsigned)(Rb * K + C) * 2u; }
    const size_t kstep = (size_t)(BK * 2);
    const size_t hstep = (size_t)HALF * K * 2;
    const size_t tstep = 2 * hstep;
    const unsigned ldsw = (unsigned)wid * 1024u;
    const int aoff = lds_byte(wr * 64 + fr, fq * 8), boff = lds_byte(wc * 32 + fr, fq * 8);
#define PG8_SA(b, h) (((b) * 2 + (h)) * HTB)
#define PG8_SB(b, h) ((4 + (b) * 2 + (h)) * HTB)
#define PG8_STAGE(bufoff, gbase, voff) do { _Pragma("unroll") for (int _i = 0; _i < 2; ++_i) \
        __builtin_amdgcn_global_load_lds((const unsigned*)((const char*)(gbase) + (voff)[_i]), (PG8_LAS unsigned*)(lds + (bufoff) + ldsw + _i * 8192), 16, 0, 0); } while (0)
#define PG8_LDA(dst, b, h) do { _Pragma("unroll") for (int m = 0; m < 4; ++m) _Pragma("unroll") for (int k = 0; k < 2; ++k) dst[m][k] = *(const PG8_LAS bf16x8*)(lds + PG8_SA(b, h) + aoff + m * 2048 + k * 1024); } while (0)
#define PG8_LDB(dst, b, h) do { _Pragma("unroll") for (int n = 0; n < 2; ++n) _Pragma("unroll") for (int k = 0; k < 2; ++k) dst[n][k] = *(const PG8_LAS bf16x8*)(lds + PG8_SB(b, h) + boff + n * 2048 + k * 1024); } while (0)
#define PG8_MMA(ai, bj, At, Bt) do { __builtin_amdgcn_s_setprio(1); _Pragma("unroll") for (int m = 0; m < 4; ++m) _Pragma("unroll") for (int n = 0; n < 2; ++n) _Pragma("unroll") for (int k = 0; k < 2; ++k) \
        acc[ai][bj][m][n] = __builtin_amdgcn_mfma_f32_16x16x32_bf16(Bt[n][k], At[m][k], acc[ai][bj][m][n], 0, 0, 0); __builtin_amdgcn_s_setprio(0); } while (0)
#define PG8_WAIT_V(n) asm volatile("s_waitcnt vmcnt(" #n ")" ::: "memory")
#define PG8_WAIT_L(n) asm volatile("s_waitcnt lgkmcnt(" #n ")" ::: "memory")
#define PG8_BAR __builtin_amdgcn_s_barrier()
#define PG8_SCHED __builtin_amdgcn_sched_barrier(0)
    Unit cur, nxt; int ui = 0;
    if (!S.next(0, cur)) return;
    f32x4 acc[2][2][4][2];
#pragma unroll
    for (int a = 0; a < 2; ++a)
#pragma unroll
        for (int b = 0; b < 2; ++b)
#pragma unroll
            for (int m = 0; m < 4; ++m)
#pragma unroll
                for (int n = 0; n < 2; ++n) acc[a][b][m][n] = (f32x4){0.f, 0.f, 0.f, 0.f};
    bf16x8 At[4][2], B0[2][2], B1[2][2];
    const char* cA = (const char*)g.A + (size_t)cur.pm * tstep; const char* cB = (const char*)g.Bt + (size_t)cur.pn * tstep;
    S.a_ready(cur);
    if constexpr (SP2) {
        PG8_STAGE(PG8_SB(0, 0), cB, voffB); PG8_STAGE(PG8_SB(0, 1), cB + hstep, voffB); PG8_STAGE(PG8_SA(0, 0), cA, voffA); PG8_STAGE(PG8_SA(0, 1), cA + hstep, voffA);
        if (wr == 1) PG8_BAR;
        PG8_WAIT_V(2); PG8_BAR;
        PG8_STAGE(PG8_SB(1, 0), cB + kstep, voffB); PG8_STAGE(PG8_SA(1, 0), cA + kstep, voffA); PG8_STAGE(PG8_SB(1, 1), cB + hstep + kstep, voffB);
        PG8_WAIT_V(6); PG8_BAR;
    } else {
        PG8_STAGE(PG8_SB(0, 0), cB, voffB); PG8_STAGE(PG8_SA(0, 0), cA, voffA); PG8_STAGE(PG8_SB(0, 1), cB + hstep, voffB); PG8_STAGE(PG8_SA(0, 1), cA + hstep, voffA);
        if (wr == 1) PG8_BAR;
        PG8_WAIT_V(4); PG8_BAR;
        PG8_STAGE(PG8_SB(1, 0), cB + kstep, voffB); PG8_STAGE(PG8_SA(1, 0), cA + kstep, voffA); PG8_STAGE(PG8_SB(1, 1), cB + hstep + kstep, voffB);
        PG8_WAIT_V(6); PG8_BAR;
    }
    for (;;) {
        const bool has_next = S.next(ui + 1, nxt);
        const char* nA = has_next ? (const char*)g.A + (size_t)nxt.pm * tstep : cA; const char* nB = has_next ? (const char*)g.Bt + (size_t)nxt.pn * tstep : cB;
        for (int t = 0; t < nt; t += 2) {
            if constexpr (Epi::HAS_MID) { if (t == (nt >> 1)) E.mid(acc, cur, wr, wc, fr, fq); }
            const bool last = (t == nt - 2);
            const char* a1 = cA + (size_t)(t + 1) * kstep;
            const char* a2 = last ? nA : cA + (size_t)(t + 2) * kstep; const char* b2 = last ? nB : cB + (size_t)(t + 2) * kstep;
            const char* a3 = a2 + kstep; const char* b3 = b2 + kstep;
            if (last && has_next) S.a_ready(nxt);
            if constexpr (SP2) {
            PG8_LDB(B0, 0, 0); PG8_LDB(B1, 0, 1); PG8_SCHED; PG8_LDA(At, 0, 0); PG8_STAGE(PG8_SA(1, 1), a1 + hstep, voffA);
            PG8_WAIT_V(8); PG8_WAIT_L(0); PG8_BAR; PG8_MMA(0, 0, At, B0); PG8_MMA(0, 1, At, B1); PG8_BAR; PG8_SCHED;
            PG8_LDA(At, 0, 1); PG8_STAGE(PG8_SB(0, 0), b2, voffB); PG8_STAGE(PG8_SB(0, 1), b2 + hstep, voffB); PG8_STAGE(PG8_SA(0, 0), a2, voffA);
            PG8_WAIT_V(8); PG8_WAIT_L(0); PG8_BAR; PG8_MMA(1, 0, At, B0); PG8_MMA(1, 1, At, B1); PG8_BAR; PG8_SCHED;
            PG8_LDB(B0, 1, 0); PG8_LDB(B1, 1, 1); PG8_SCHED; PG8_LDA(At, 1, 0); PG8_STAGE(PG8_SA(0, 1), a2 + hstep, voffA);
            PG8_WAIT_V(8); PG8_WAIT_L(0); PG8_BAR; PG8_MMA(0, 0, At, B0); PG8_MMA(0, 1, At, B1); PG8_BAR; PG8_SCHED;
            PG8_LDA(At, 1, 1); PG8_STAGE(PG8_SB(1, 0), b3, voffB); PG8_STAGE(PG8_SB(1, 1), b3 + hstep, voffB); PG8_STAGE(PG8_SA(1, 0), a3, voffA);
            PG8_WAIT_V(8); PG8_WAIT_L(0); PG8_BAR; PG8_MMA(1, 0, At, B0); PG8_MMA(1, 1, At, B1); PG8_BAR; PG8_SCHED;
            } else {
            PG8_LDB(B0, 0, 0); PG8_SCHED; PG8_LDA(At, 0, 0); PG8_STAGE(PG8_SA(1, 1), a1 + hstep, voffA);
            PG8_WAIT_L(8); PG8_BAR; PG8_WAIT_L(0); PG8_MMA(0, 0, At, B0); PG8_BAR; PG8_SCHED;
            PG8_LDB(B1, 0, 1); PG8_STAGE(PG8_SB(0, 0), b2, voffB);
            PG8_BAR; PG8_WAIT_L(0); PG8_MMA(0, 1, At, B1); PG8_BAR;
            PG8_LDA(At, 0, 1); PG8_STAGE(PG8_SA(0, 0), a2, voffA);
            PG8_BAR; PG8_WAIT_L(0); PG8_MMA(1, 0, At, B0); PG8_BAR; PG8_SCHED;
            PG8_STAGE(PG8_SB(0, 1), b2 + hstep, voffB);
            PG8_WAIT_V(6); PG8_BAR; PG8_MMA(1, 1, At, B1); PG8_BAR;
            PG8_LDB(B0, 1, 0); PG8_SCHED; PG8_LDA(At, 1, 0); PG8_STAGE(PG8_SA(0, 1), a2 + hstep, voffA);
            PG8_WAIT_L(8); PG8_BAR; PG8_WAIT_L(0); PG8_MMA(0, 0, At, B0); PG8_BAR; PG8_SCHED;
            PG8_LDB(B1, 1, 1); PG8_STAGE(PG8_SB(1, 0), b3, voffB);
            PG8_BAR; PG8_WAIT_L(0); PG8_MMA(0, 1, At, B1); PG8_BAR;
            PG8_LDA(At, 1, 1); PG8_STAGE(PG8_SA(1, 0), a3, voffA);
            PG8_BAR; PG8_WAIT_L(0); PG8_MMA(1, 0, At, B0); PG8_BAR; PG8_SCHED;
            PG8_STAGE(PG8_SB(1, 1), b3 + hstep, voffB);
            PG8_WAIT_V(6); PG8_BAR; PG8_MMA(1, 1, At, B1); PG8_BAR;
            }
        }
        if constexpr (ALIGN_EPI) { if (wr == 0) PG8_BAR; }
        if constexpr (!Epi::AFTER_DRAIN) { E(acc, cur, wr, wc, fr, fq); S.done(cur); }
        if (!has_next) break;
#pragma unroll
        for (int a = 0; a < 2; ++a)
#pragma unroll
            for (int b = 0; b < 2; ++b)
#pragma unroll
                for (int m = 0; m < 4; ++m)
#pragma unroll
                    for (int n = 0; n < 2; ++n) acc[a][b][m][n] = (f32x4){0.f, 0.f, 0.f, 0.f};
        cur = nxt; cA = nA; cB = nB; ++ui;
        if constexpr (ALIGN_EPI) { if (wr == 1) PG8_BAR; }
    }
    PG8_WAIT_V(0);
    if constexpr (!ALIGN_EPI) { if (wr == 0) PG8_BAR; }
    PG8_BAR;
    if constexpr (Epi::AFTER_DRAIN) { E.fused(acc, cur, wr, wc, fr, fq, lds, wid, lane); S.done(cur); }
#undef PG8_SA
#undef PG8_SB
#undef PG8_STAGE
#undef PG8_LDA
#undef PG8_LDB
#undef PG8_MMA
#undef PG8_WAIT_V
#undef PG8_WAIT_L
#undef PG8_BAR
#undef PG8_SCHED
}
}
#ifndef REP_PHASE
#define REP_PHASE -1
#endif
#define NREP(k) ((k) == REP_PHASE ? 2 : 1)

constexpr int S = 16384, D = 1024, NIN = 4608, FFH = 2816, NGU = 2 * FFH;
constexpr int NHEAD = 12, HD = 64;
constexpr float EPS = 1e-6f;
constexpr int LDS_BYTES = 147456;
constexpr int NPHASE = 10;

#define LAS __attribute__((address_space(3)))
typedef unsigned short bf16_t;
typedef short bf16x8 __attribute__((ext_vector_type(8)));
typedef float f32x4 __attribute__((ext_vector_type(4)));
typedef unsigned u32x4 __attribute__((ext_vector_type(4)));
typedef unsigned u32x2 __attribute__((ext_vector_type(2)));

constexpr size_t MiB = 1u << 20;
constexpr size_t WS_WIN = 0;
constexpr size_t WS_WPA = 9 * MiB;
constexpr size_t WS_WOUT = 10 * MiB;
constexpr size_t WS_WGU = 12 * MiB;
constexpr size_t WS_WD = 23 * MiB;
constexpr size_t WS_WMT = 29 * MiB;
constexpr size_t WS_TAB = 30 * MiB;
constexpr size_t WS_H = 34 * MiB;
constexpr size_t WS_QKV = 66 * MiB;
constexpr size_t WS_U = 138 * MiB;
constexpr size_t WS_GATES = 146 * MiB;
constexpr size_t WS_OG = 210 * MiB;
constexpr size_t WS_LSE = 234 * MiB;
constexpr size_t WS_OA = 235 * MiB;
constexpr size_t WS_H2 = 154 * MiB;
constexpr size_t WS_X1 = 186 * MiB;
constexpr size_t WS_ACT = 66 * MiB;
constexpr size_t WS_CTL = 251 * MiB;
constexpr size_t CTL_ZERO_BYTES = 131072;
constexpr int CW_XBAR = 16384;
constexpr size_t WS_XBUF = 251 * MiB + 131072;
constexpr size_t WS_END = (REP_PHASE >= 0 ? 253 : 252) * MiB;

__device__ __forceinline__ float bf2f(unsigned bits16) { return __builtin_bit_cast(float, bits16 << 16); }
typedef float f32x2_t __attribute__((ext_vector_type(2)));
typedef __bf16 bf16x2_t __attribute__((ext_vector_type(2)));
__device__ __forceinline__ unsigned pk2(float lo, float hi) { f32x2_t v = {lo, hi}; bf16x2_t b = __builtin_convertvector(v, bf16x2_t); return __builtin_bit_cast(unsigned, b); }
__device__ __forceinline__ float wave_sum(float v) {
#pragma unroll
    for (int o = 1; o < 64; o <<= 1) v += __shfl_xor(v, o);
    return v;
}
__device__ __forceinline__ int lane_id_asm() { int l; asm volatile("v_mbcnt_lo_u32_b32 %0, -1, 0\n\tv_mbcnt_hi_u32_b32 %0, -1, %0" : "=v"(l)); return l; }
__device__ __forceinline__ float sigmoidf_(float v) { return __builtin_amdgcn_rcpf(1.0f + __builtin_amdgcn_exp2f(v * -1.4426950408889634f)); }

__host__ __device__ __forceinline__ int in_tile(int pn) { return pn < 8 ? pn + 10 : (pn < 14 ? pn - 8 : (pn == 14 ? 9 : pn - 9)); }
#define OPQ(p) asm volatile("" : "+v"(p))
#define EPI_ROWS_BEGIN _Pragma("unroll") for (int ai = 0; ai < 2; ++ai) { _Pragma("unroll") for (int m = 0; m < 4; ++m) {
#define EPI_ROWS_END(step16, step64) } }
struct EpiIn {
    static constexpr bool PERM = true, AFTER_DRAIN = false, HAS_MID = false;
    bf16_t* qkv; bf16_t* ub; bf16_t* gates; const float* tab;
    __device__ __forceinline__ void operator()(const f32x4 (&acc)[2][2][4][2], const pg8::Unit& u, int wr, int wc, int fr, int fq) const {
        const int pn = in_tile(u.pn);
        const int r0 = u.pm * 256 + wr * 64 + fr;
        if (pn < 6) {
            const int T = pn / 3, g3 = pn - 3 * T, sh = 2 * g3;
            const int rowp0 = ((r0 & ((1 << sh) - 1)) << (14 - sh)) + (r0 >> sh);
            bf16_t* dst = qkv + (((size_t)T * NHEAD + g3 * 4 + wc) * S + rowp0) * HD + 8 * fq;
            const float* tp = tab + ((size_t)r0 * 32 + 8 * fq) * 2;
            const int dstep = (16 >> sh) * HD;
#pragma unroll
            for (int ai = 0; ai < 2; ++ai) {
#pragma unroll
                for (int m = 0; m < 4; ++m) {
                    u32x4 w1, w2;
#pragma unroll
                    for (int n = 0; n < 2; ++n) {
                        const f32x4 cs0 = *(const f32x4*)(tp + 8 * n), cs1 = *(const f32x4*)(tp + 8 * n + 4);
                        const f32x4 a = acc[ai][0][m][n], b = acc[ai][1][m][n];
                        const float o10 = a[0] * cs0[0] - b[0] * cs0[1], o20 = b[0] * cs0[0] + a[0] * cs0[1];
                        const float o11 = a[1] * cs0[2] - b[1] * cs0[3], o21 = b[1] * cs0[2] + a[1] * cs0[3];
                        const float o12 = a[2] * cs1[0] - b[2] * cs1[1], o22 = b[2] * cs1[0] + a[2] * cs1[1];
                        const float o13 = a[3] * cs1[2] - b[3] * cs1[3], o23 = b[3] * cs1[2] + a[3] * cs1[3];
                        w1[2 * n] = pk2(o10, o11); w1[2 * n + 1] = pk2(o12, o13); w2[2 * n] = pk2(o20, o21); w2[2 * n + 1] = pk2(o22, o23);
                    }
                    *(u32x4*)dst = w1; *(u32x4*)(dst + 32) = w2;
                    dst += dstep; tp += 16 * 64; OPQ(dst); OPQ(tp);
                }
                dst += 4 * dstep; tp += 64 * 64; OPQ(dst); OPQ(tp);
            }
        } else if (pn < 9) {
            const int g3 = pn - 6, sh = 2 * g3;
            const int rowp0 = ((r0 & ((1 << sh) - 1)) << (14 - sh)) + (r0 >> sh);
            bf16_t* dst = qkv + (((size_t)2 * NHEAD + g3 * 4 + (wc >> 1)) * S + rowp0) * HD + 32 * (wc & 1) + 8 * fq;
            const int dstep = (16 >> sh) * HD;
#pragma unroll
            for (int ai = 0; ai < 2; ++ai) {
#pragma unroll
                for (int m = 0; m < 4; ++m) {
#pragma unroll
                    for (int bj = 0; bj < 2; ++bj) { const f32x4 a0 = acc[ai][bj][m][0], a1 = acc[ai][bj][m][1];
                        u32x4 wv; wv.x = pk2(a0[0], a0[1]); wv.y = pk2(a0[2], a0[3]); wv.z = pk2(a1[0], a1[1]); wv.w = pk2(a1[2], a1[3]); *(u32x4*)(dst + (size_t)bj * 2 * S * HD) = wv; }
                    dst += dstep; OPQ(dst);
                }
                dst += 4 * dstep; OPQ(dst);
            }
        } else if (pn == 9) {
            bf16_t* dst = ub + (size_t)r0 * 256 + 32 * wc + 8 * fq;
#pragma unroll
            for (int ai = 0; ai < 2; ++ai) {
#pragma unroll
                for (int m = 0; m < 4; ++m) {
#pragma unroll
                    for (int bj = 0; bj < 2; ++bj) { const f32x4 a0 = acc[ai][bj][m][0], a1 = acc[ai][bj][m][1];
                        u32x4 wv; wv.x = pk2(a0[0], a0[1]); wv.y = pk2(a0[2], a0[3]); wv.z = pk2(a1[0], a1[1]); wv.w = pk2(a1[2], a1[3]); *(u32x4*)(dst + 128 * bj) = wv; }
                    dst += 16 * 256; OPQ(dst);
                }
                dst += 64 * 256; OPQ(dst);
            }
        } else {
            const int tg = pn - 10, wid = wr * 4 + wc, lane = fq * 16 + fr;
            unsigned char* dst = (unsigned char*)gates + ((size_t)(u.pm * 8 + tg) * 2) * 65536 + (wid * 64 + lane) * 16;
#pragma unroll
            for (int ai = 0; ai < 2; ++ai)
#pragma unroll
                for (int m = 0; m < 4; ++m) {
                    u32x4 w0, w1;
#pragma unroll
                    for (int n = 0; n < 2; ++n) {
                        const f32x4 a = acc[ai][0][m][n], b = acc[ai][1][m][n];
                        f32x4 ra, sp;
#pragma unroll
                        for (int j = 0; j < 4; ++j) { const float pa = 1.0f + __builtin_amdgcn_exp2f(fminf(a[j] * -1.4426950408889634f, 60.0f)), pb = 1.0f + __builtin_amdgcn_exp2f(fminf(b[j] * -1.4426950408889634f, 60.0f));
                            const float rr = __builtin_amdgcn_rcpf(pa * pb);
                            sp[j] = pa * rr; ra[j] = pb * pb * rr; }
                        w0[2 * n] = pk2(ra[0], ra[1]); w0[2 * n + 1] = pk2(ra[2], ra[3]); w1[2 * n] = pk2(sp[0], sp[1]); w1[2 * n + 1] = pk2(sp[2], sp[3]);
                    }
                    *(u32x4*)dst = w0; *(u32x4*)(dst + 65536) = w1;
                    dst += 8192; OPQ(dst);
                }
        }
    }
};

struct EpiGate2 {
    static constexpr bool PERM = true, AFTER_DRAIN = false, HAS_MID = true;
    const bf16_t* gates; bf16_t* merged;
    __device__ __forceinline__ void mid(f32x4 (&acc)[2][2][4][2], const pg8::Unit& u, int wr, int wc, int fr, int fq) const {
        const int wid = wr * 4 + wc, lane = fq * 16 + fr;
#pragma unroll
        for (int bj = 0; bj < 2; ++bj) {
            const unsigned char* gp = (const unsigned char*)gates + ((size_t)(u.pm * 8 + 2 * u.pn + bj) * 2) * 65536 + (wid * 64 + lane) * 16;
#pragma unroll
            for (int ai = 0; ai < 2; ++ai)
#pragma unroll
                for (int m = 0; m < 4; ++m) {
                    const u32x4 ga = __builtin_nontemporal_load((const u32x4*)gp);
#pragma unroll
                    for (int n = 0; n < 2; ++n) { f32x4 ra; ra[0] = bf2f(ga[2 * n] & 0xffffu); ra[1] = bf2f(ga[2 * n] >> 16); ra[2] = bf2f(ga[2 * n + 1] & 0xffffu); ra[3] = bf2f(ga[2 * n + 1] >> 16);
                        acc[ai][bj][m][n] = acc[ai][bj][m][n] * ra; }
                    gp += 8192; OPQ(gp);
                }
        }
    }
    __device__ __forceinline__ void operator()(const f32x4 (&acc)[2][2][4][2], const pg8::Unit& u, int wr, int wc, int fr, int fq) const {
        const int wid = wr * 4 + wc, lane = fq * 16 + fr;
        const int r0 = u.pm * 256 + wr * 64 + fr, c0 = u.pn * 256 + 32 * wc + 8 * fq;
#pragma unroll
        for (int bj = 0; bj < 2; ++bj) {
            const unsigned char* gp = (const unsigned char*)gates + ((size_t)(u.pm * 8 + 2 * u.pn + bj) * 2 + 1) * 65536 + (wid * 64 + lane) * 16;
            bf16_t* mp = merged + (size_t)r0 * D + c0 + 128 * bj;
#pragma unroll
            for (int ai = 0; ai < 2; ++ai) {
#pragma unroll
                for (int m = 0; m < 4; ++m) {
                    const u32x4 gw = __builtin_nontemporal_load((const u32x4*)gp);
                    u32x4 wv;
#pragma unroll
                    for (int n = 0; n < 2; ++n) { f32x4 g; g[0] = bf2f(gw[2 * n] & 0xffffu); g[1] = bf2f(gw[2 * n] >> 16); g[2] = bf2f(gw[2 * n + 1] & 0xffffu); g[3] = bf2f(gw[2 * n + 1] >> 16);
                        const f32x4 o = acc[ai][bj][m][n] * g; wv[2 * n] = pk2(o[0], o[1]); wv[2 * n + 1] = pk2(o[2], o[3]); }
                    *(u32x4*)mp = wv;
                    gp += 8192; OPQ(gp);
                    mp += 16 * D; OPQ(mp);
                }
                mp += 64 * D; OPQ(mp);
            }
        }
    }
};

struct EpiF32 {
    static constexpr bool PERM = false, AFTER_DRAIN = false, HAS_MID = false;
    float* out; int ldc;
    __device__ __forceinline__ void operator()(const f32x4 (&acc)[2][2][4][2], const pg8::Unit& u, int wr, int wc, int fr, int fq) const {
        float* op = out + (size_t)(u.pm * 256 + wr * 64 + fr) * ldc + u.pn * 256 + 32 * wc + 4 * fq;
#pragma unroll
        for (int ai = 0; ai < 2; ++ai) {
#pragma unroll
            for (int m = 0; m < 4; ++m) {
#pragma unroll
                for (int bj = 0; bj < 2; ++bj)
#pragma unroll
                    for (int n = 0; n < 2; ++n) *(f32x4*)(op + 128 * bj + 16 * n) = acc[ai][bj][m][n];
                op += 16 * (size_t)ldc; OPQ(op);
            }
            op += 64 * (size_t)ldc; OPQ(op);
        }
    }
};

struct EpiSwiglu {
    static constexpr bool PERM = true, AFTER_DRAIN = false, HAS_MID = false;
    bf16_t* act;
    __device__ __forceinline__ void operator()(const f32x4 (&acc)[2][2][4][2], const pg8::Unit& u, int wr, int wc, int fr, int fq) const {
        bf16_t* op = act + (size_t)(u.pm * 256 + wr * 64 + fr) * FFH + u.pn * 128 + 32 * wc + 8 * fq;
#pragma unroll
        for (int ai = 0; ai < 2; ++ai) {
#pragma unroll
            for (int m = 0; m < 4; ++m) {
                u32x4 wv;
#pragma unroll
                for (int n = 0; n < 2; ++n) {
                    const f32x4 a = acc[ai][0][m][n], b = acc[ai][1][m][n];
                    f32x4 o;
#pragma unroll
                    for (int j = 0; j < 4; ++j) o[j] = a[j] * sigmoidf_(a[j]) * b[j];
                    wv[2 * n] = pk2(o[0], o[1]); wv[2 * n + 1] = pk2(o[2], o[3]);
                }
                __builtin_nontemporal_store(wv, (u32x4*)op);
                op += 16 * FFH; OPQ(op);
            }
            op += 64 * FFH; OPQ(op);
        }
    }
};

struct RowStats {
    unsigned* xbuf;
    unsigned* cnt;
    __device__ __forceinline__ void run(const f32x4 (&v)[2][2][4][2], const pg8::Unit& u, int wr, int wc, int fr, int fq, LAS unsigned char* lds, int wid, int lane) const {
        LAS float* P = (LAS float*)lds;
        LAS float* Sg = (LAS float*)(lds + 8192);
#pragma unroll
        for (int ai = 0; ai < 2; ++ai)
#pragma unroll
            for (int m = 0; m < 4; ++m) {
                float q = 0.f;
#pragma unroll
                for (int bj = 0; bj < 2; ++bj)
#pragma unroll
                    for (int n = 0; n < 2; ++n) { const f32x4 d = v[ai][bj][m][n]; q += (d[0] * d[0] + d[1] * d[1]) + (d[2] * d[2] + d[3] * d[3]); }
                q += __shfl_xor(q, 16); q += __shfl_xor(q, 32);
                if (fq == 0) P[(ai * 128 + wr * 64 + m * 16 + fr) * 4 + wc] = q;
            }
        asm volatile("s_waitcnt lgkmcnt(0)" ::: "memory"); __builtin_amdgcn_s_barrier(); asm volatile("" ::: "memory");
        const int row = wid * 32 + (lane & 31);
        if (lane < 32) {
            const float tot = (P[row * 4 + 0] + P[row * 4 + 1]) + (P[row * 4 + 2] + P[row * 4 + 3]);
            __hip_atomic_store(xbuf + ((size_t)(u.pm * 256 + row) * 4 + u.pn), __builtin_bit_cast(unsigned, tot), __ATOMIC_RELAXED, __HIP_MEMORY_SCOPE_AGENT);
        }
        asm volatile("s_waitcnt vmcnt(0)" ::: "memory");
        if (lane == 0) __hip_atomic_fetch_add(cnt + 64 * u.pm, 1u, __ATOMIC_RELAXED, __HIP_MEMORY_SCOPE_AGENT);
        if (wid == 0) {
            unsigned spins = 0;
            while ((unsigned)__builtin_amdgcn_readfirstlane(__hip_atomic_load(cnt + 64 * u.pm, __ATOMIC_RELAXED, __HIP_MEMORY_SCOPE_AGENT)) < 32u) {
                __builtin_amdgcn_s_sleep(2); if (++spins > (1u << 22)) break; }
            __builtin_amdgcn_fence(__ATOMIC_ACQUIRE, "agent");
        }
        asm volatile("s_waitcnt vmcnt(0) lgkmcnt(0)" ::: "memory"); __builtin_amdgcn_s_barrier(); asm volatile("" ::: "memory");
        if (lane < 32) {
            const unsigned* slot = xbuf + (size_t)(u.pm * 256 + row) * 4; float t[4];
#pragma unroll
            for (int k = 0; k < 4; ++k) t[k] = __builtin_bit_cast(float, __hip_atomic_load(slot + k, __ATOMIC_RELAXED, __HIP_MEMORY_SCOPE_AGENT));
            Sg[row] = 1.0f / sqrtf(((t[0] + t[1]) + (t[2] + t[3])) * (1.0f / D) + EPS);
        }
        asm volatile("s_waitcnt lgkmcnt(0)" ::: "memory"); __builtin_amdgcn_s_barrier(); asm volatile("" ::: "memory");
    }
};
struct EpiRmsResRms {
    static constexpr bool PERM = true, AFTER_DRAIN = true, HAS_MID = false;
    const float* base; bf16_t* x1b; bf16_t* xn; const float* g1; const float* g2; RowStats st1, st2;
    __device__ __forceinline__ void fused(f32x4 (&acc)[2][2][4][2], const pg8::Unit& u, int wr, int wc, int fr, int fq, LAS unsigned char* lds, int wid, int lane) const {
        const LAS float* Sg = (const LAS float*)(lds + 8192);
        const int col0 = u.pn * 256 + wc * 32 + 8 * fq;
        const float* bp = base + (size_t)(u.pm * 256 + wr * 64 + fr) * D + col0;
        f32x4 pre[4][2][2];
#pragma unroll
        for (int m = 0; m < 4; ++m)
#pragma unroll
            for (int bj = 0; bj < 2; ++bj)
#pragma unroll
                for (int n = 0; n < 2; ++n) pre[m][bj][n] = __builtin_nontemporal_load((const f32x4*)(bp + (size_t)m * 16 * D + bj * 128 + n * 4));
        st1.run(acc, u, wr, wc, fr, fq, lds, wid, lane);
        {
            f32x4 gv[2][2];
#pragma unroll
            for (int bj = 0; bj < 2; ++bj)
#pragma unroll
                for (int n = 0; n < 2; ++n) gv[bj][n] = *(const f32x4*)(g1 + col0 + bj * 128 + n * 4);
#pragma unroll
            for (int ai = 0; ai < 2; ++ai) {
#pragma unroll
                for (int m = 0; m < 4; ++m) {
                    const float r1 = Sg[ai * 128 + wr * 64 + m * 16 + fr];
#pragma unroll
                    for (int bj = 0; bj < 2; ++bj)
#pragma unroll
                        for (int n = 0; n < 2; ++n) { const f32x4 bs = pre[m][bj][n]; acc[ai][bj][m][n] = bs + acc[ai][bj][m][n] * r1 * gv[bj][n]; }
                    if (ai == 0) {
#pragma unroll
                        for (int bj = 0; bj < 2; ++bj)
#pragma unroll
                            for (int n = 0; n < 2; ++n) pre[m][bj][n] = __builtin_nontemporal_load((const f32x4*)(bp + (size_t)128 * D + bj * 128 + n * 4));
                    }
                    asm volatile("" : "+v"(acc[ai][0][m][0]), "+v"(acc[ai][0][m][1]), "+v"(acc[ai][1][m][0]), "+v"(acc[ai][1][m][1]));
                    bp += 16 * D; OPQ(bp);
                    if (m & 1) asm volatile("" ::: "memory");
                }
                bp += 64 * D; OPQ(bp);
            }
        }
        st2.run(acc, u, wr, wc, fr, fq, lds, wid, lane);
        {
            f32x4 gv[2][2];
#pragma unroll
            for (int bj = 0; bj < 2; ++bj)
#pragma unroll
                for (int n = 0; n < 2; ++n) gv[bj][n] = *(const f32x4*)(g2 + col0 + bj * 128 + n * 4);
            bf16_t* op = x1b + (size_t)(u.pm * 256 + wr * 64 + fr) * D + col0; bf16_t* xp = xn + (size_t)(u.pm * 256 + wr * 64 + fr) * D + col0;
#pragma unroll
            for (int ai = 0; ai < 2; ++ai) {
#pragma unroll
                for (int m = 0; m < 4; ++m) {
                    const float r2 = Sg[ai * 128 + wr * 64 + m * 16 + fr];
#pragma unroll
                    for (int bj = 0; bj < 2; ++bj) { u32x4 wx, wv;
#pragma unroll
                        for (int n = 0; n < 2; ++n) { const f32x4 x1 = acc[ai][bj][m][n]; wx[2 * n] = pk2(x1[0], x1[1]); wx[2 * n + 1] = pk2(x1[2], x1[3]);
                            const f32x4 o = x1 * r2 * gv[bj][n]; wv[2 * n] = pk2(o[0], o[1]); wv[2 * n + 1] = pk2(o[2], o[3]); }
                        *(u32x4*)(op + bj * 128) = wx; *(u32x4*)(xp + bj * 128) = wv; }
                    op += 16 * D; xp += 16 * D; OPQ(op); OPQ(xp);
                }
                op += 64 * D; xp += 64 * D; OPQ(op); OPQ(xp);
            }
        }
    }
};
struct EpiRmsRes {
    static constexpr bool PERM = true, AFTER_DRAIN = true, HAS_MID = false;
    const bf16_t* x1b; float* out; const float* g1; RowStats st;
    __device__ __forceinline__ void fused(f32x4 (&acc)[2][2][4][2], const pg8::Unit& u, int wr, int wc, int fr, int fq, LAS unsigned char* lds, int wid, int lane) const {
        const LAS float* Sg = (const LAS float*)(lds + 8192);
        const int col0 = u.pn * 256 + wc * 32 + 8 * fq;
        const bf16_t* bp = x1b + (size_t)(u.pm * 256 + wr * 64 + fr) * D + col0; float* op = out + (size_t)(u.pm * 256 + wr * 64 + fr) * D + col0;
        u32x4 pre[2][4][2];
#pragma unroll
        for (int ai = 0; ai < 2; ++ai)
#pragma unroll
            for (int m = 0; m < 4; ++m)
#pragma unroll
                for (int bj = 0; bj < 2; ++bj) pre[ai][m][bj] = __builtin_nontemporal_load((const u32x4*)(bp + (size_t)(ai * 128 + m * 16) * D + bj * 128));
        st.run(acc, u, wr, wc, fr, fq, lds, wid, lane);
        f32x4 gv[2][2];
#pragma unroll
        for (int bj = 0; bj < 2; ++bj)
#pragma unroll
            for (int n = 0; n < 2; ++n) gv[bj][n] = *(const f32x4*)(g1 + col0 + bj * 128 + n * 4);
#pragma unroll
        for (int ai = 0; ai < 2; ++ai) {
#pragma unroll
            for (int m = 0; m < 4; ++m) {
                const float r1 = Sg[ai * 128 + wr * 64 + m * 16 + fr];
#pragma unroll
                for (int bj = 0; bj < 2; ++bj)
#pragma unroll
                    for (int n = 0; n < 2; ++n) { const unsigned px = pre[ai][m][bj][2 * n], py = pre[ai][m][bj][2 * n + 1]; f32x4 bs; bs[0] = bf2f(px & 0xffffu); bs[1] = bf2f(px >> 16); bs[2] = bf2f(py & 0xffffu); bs[3] = bf2f(py >> 16);
                        *(f32x4*)(op + bj * 128 + n * 4) = bs + acc[ai][bj][m][n] * r1 * gv[bj][n]; }
                op += 16 * D; OPQ(op);
            }
            op += 64 * D; OPQ(op);
        }
    }
};

template <int MAP> __device__ __forceinline__ int src_col(int s) {
    if (MAP == 1) s = in_tile(s >> 8) * 256 + (s & 255);
    if (MAP == 1) { if (s < 1536) { const int bj = (s >> 7) & 1, wc = (s >> 5) & 3, rest = s & 31; return (s & ~255) + 64 * wc + 32 * bj + rest; }
                    if (s >= 2560) { const int tg = (s - 2560) >> 8, bj = (s >> 7) & 1, cc = s & 127; return 2560 + bj * 1024 + 128 * tg + cc; } return s; }
    if (MAP == 2) { const int pn = s >> 8, bj = (s >> 7) & 1, cc = s & 127; return bj * FFH + 128 * pn + cc; }
    return s;
}
template <int MAP> __device__ __forceinline__ void transpose_item(const float* W, int K, int N, bf16_t* WT, LAS float* scr, int item, int lane, int ldk = 0) {
    const int nblk = N / 32, kb = item / nblk, nb = item % nblk, k0 = 64 * kb, n0 = 32 * nb;
    const int sc = src_col<MAP>(n0 + (lane & 31));
    float tv[32];
#pragma unroll
    for (int i = 0; i < 32; ++i) tv[i] = __builtin_nontemporal_load(W + (size_t)(k0 + 2 * i + (lane >> 5)) * N + sc);
#pragma unroll
    for (int i = 0; i < 32; ++i) scr[(2 * i + (lane >> 5)) * 33 + (lane & 31)] = tv[i];
    asm volatile("s_waitcnt lgkmcnt(0)" ::: "memory");
    const int c = lane & 7;
#pragma unroll
    for (int j = 0; j < 4; ++j) { const int n = (lane >> 3) + 8 * j; const LAS float* s = scr + (8 * c) * 33 + n;
        u32x4 o; o.x = pk2(s[0 * 33], s[1 * 33]); o.y = pk2(s[2 * 33], s[3 * 33]); o.z = pk2(s[4 * 33], s[5 * 33]); o.w = pk2(s[6 * 33], s[7 * 33]);
        *(u32x4*)(WT + (size_t)(n0 + n) * (ldk ? ldk : K) + k0 + 8 * c) = o; }
    asm volatile("s_waitcnt lgkmcnt(0)" ::: "memory");
}

template <int MAP> __device__ __forceinline__ void transpose_sub(const float* W, int K, int N, bf16_t* WT, LAS float* scr, int item, int sub, int lane) {
    const int nblk = N / 32, kb = item / nblk, nb = item % nblk, k0 = 64 * kb + 8 * sub, n0 = 32 * nb;
    const int sc = src_col<MAP>(n0 + (lane & 31));
    float tv[4];
#pragma unroll
    for (int i = 0; i < 4; ++i) tv[i] = __builtin_nontemporal_load(W + (size_t)(k0 + 2 * i + (lane >> 5)) * N + sc);
#pragma unroll
    for (int i = 0; i < 4; ++i) scr[(2 * i + (lane >> 5)) * 33 + (lane & 31)] = tv[i];
    asm volatile("s_waitcnt lgkmcnt(0)" ::: "memory");
    if (lane < 32) { const LAS float* sp = scr + lane;
        u32x4 o; o.x = pk2(sp[0 * 33], sp[1 * 33]); o.y = pk2(sp[2 * 33], sp[3 * 33]); o.z = pk2(sp[4 * 33], sp[5 * 33]); o.w = pk2(sp[6 * 33], sp[7 * 33]);
        *(u32x4*)(WT + (size_t)(n0 + lane) * K + k0) = o; }
    asm volatile("s_waitcnt lgkmcnt(0)" ::: "memory");
}

template <int W> __device__ __forceinline__ void pool_unit(const bf16_t* Ub, const bf16_t* WmT, const float* pool_scale, bf16_t* YP, int tt, int g, int c, int q) {
    const int t = 16 * tt + c;
    const int cnt = (t + 1 < W) ? t + 1 : W; const float rc = 1.0f / (float)cnt;
    bf16x8 zf[2];
#pragma unroll
    for (int kc = 0; kc < 2; ++kc) {
        const bf16_t* up = Ub + (size_t)t * 256 + g * 64 + 32 * kc + 8 * q;
        u32x4 v[W];
#pragma unroll
        for (int i = 0; i < W; ++i) { const int ti = (i <= t) ? i : 0; v[i] = *(const u32x4*)(up - (size_t)ti * 256); }
        float sum[8];
#pragma unroll
        for (int e = 0; e < 8; ++e) sum[e] = 0.f;
#pragma unroll
        for (int i = 0; i < W; ++i) { const float wgt = (i <= t) ? 1.0f : 0.0f;
#pragma unroll
            for (int e = 0; e < 4; ++e) { sum[2 * e] += wgt * bf2f(v[i][e] & 0xffffu); sum[2 * e + 1] += wgt * bf2f(v[i][e] >> 16); } }
        u32x4 zw;
#pragma unroll
        for (int e = 0; e < 4; ++e) zw[e] = pk2(sum[2 * e] * rc - bf2f(v[0][e] & 0xffffu), sum[2 * e + 1] * rc - bf2f(v[0][e] >> 16));
        zf[kc] = __builtin_bit_cast(bf16x8, zw);
    }
#pragma unroll
    for (int dt = 0; dt < 4; ++dt) {
        const bf16_t* wp = WmT + (size_t)g * 4096 + (16 * dt + c) * 64 + 8 * q;
        const bf16x8 a0 = *(const bf16x8*)wp, a1 = *(const bf16x8*)(wp + 32);
        f32x4 a = (f32x4){0.f, 0.f, 0.f, 0.f};
        a = __builtin_amdgcn_mfma_f32_16x16x32_bf16(a0, zf[0], a, 0, 0, 0);
        a = __builtin_amdgcn_mfma_f32_16x16x32_bf16(a1, zf[1], a, 0, 0, 0);
        const f32x4 scl = *(const f32x4*)(pool_scale + g * 64 + 16 * dt + 4 * q);
        u32x2 wv; wv.x = pk2(a[0] * scl[0], a[1] * scl[1]); wv.y = pk2(a[2] * scl[2], a[3] * scl[3]);
        *(u32x2*)(YP + (size_t)t * 512 + 256 + g * 64 + 16 * dt + 4 * q) = wv;
    }
}

#define XB_TMO      128
#define XB_XCNT(j)  (256  + 64 * (j))
#define XB_XSUB(j)  (1280 + 64 * (j))
#define XB_XGEN(j)  (2304 + 64 * (j))
#define XB_TOP      3328
#define XB_TOPGEN   3392
#define XCD_BAR_WORDS 3456
#define XB_SPIN_CAP (1u << 18)

__device__ __forceinline__ unsigned xb_ld(unsigned* p)              { return __hip_atomic_load(p, __ATOMIC_RELAXED, __HIP_MEMORY_SCOPE_AGENT); }
__device__ __forceinline__ unsigned xb_add(unsigned* p, unsigned v) { return __hip_atomic_fetch_add(p, v, __ATOMIC_RELAXED, __HIP_MEMORY_SCOPE_AGENT); }
__device__ __forceinline__ unsigned xb_xcc_id() { return (unsigned)__builtin_amdgcn_s_getreg((3 << 11) | 20) & 0xFu; }
#define XB_SPIN(cond, bar) do { unsigned _sp = 0; while (cond) { __builtin_amdgcn_s_sleep(1); \
    if ((++_sp & 255u) == 0u) { if (xb_ld(&(bar)[XB_TMO])) break; if (_sp > XB_SPIN_CAP) { atomicAdd(&(bar)[XB_TMO], 1u); break; } } } } while (0)

struct XcdBarrier {
    unsigned* bar; unsigned x;
    volatile LAS unsigned* st;
};

__device__ __forceinline__ XcdBarrier xcd_barrier_post(unsigned* bar, volatile LAS unsigned* st) {
    XcdBarrier b; b.bar = bar; b.x = xb_xcc_id(); b.st = st;
    if (threadIdx.x == 0) (void)xb_add(&bar[XB_XCNT(b.x)], 1u);
    return b;
}
__device__ __forceinline__ void xcd_barrier_complete(unsigned* bar, unsigned x, unsigned& nloc, unsigned& nx) {
    const unsigned G = gridDim.x * gridDim.y * gridDim.z;
    unsigned sum, cnt, mine, sp = 0u;
    for (;;) {
        sum = 0u; cnt = 0u; mine = 0u;
#pragma unroll
        for (unsigned j = 0; j < 16; ++j) { const unsigned c = xb_ld(&bar[XB_XCNT(j)]); sum += c; cnt += (c > 0u) ? 1u : 0u; mine = (j == x) ? c : mine; }
        if (sum == G) break;
        __builtin_amdgcn_s_sleep(1);
        if ((++sp & 255u) == 0u) { if (xb_ld(&bar[XB_TMO])) break; if (sp > XB_SPIN_CAP) { atomicAdd(&bar[XB_TMO], 1u); break; } }
    }
    nloc = mine > 0u ? mine : 1u; nx = cnt > 0u ? cnt : 1u;
}

__device__ __forceinline__ void xcd_barrier(const XcdBarrier& b) {
    asm volatile("s_waitcnt vmcnt(0)" ::: "memory");
    __syncthreads();
    if (threadIdx.x == 0) {
        unsigned* bar = b.bar;
        __builtin_amdgcn_s_waitcnt(0);
        unsigned nloc = b.st[0], nx = b.st[1];
        if (nloc == 0u) { xcd_barrier_complete(bar, b.x, nloc, nx); b.st[0] = nloc; b.st[1] = nx; }
        const unsigned old = xb_add(&bar[XB_XSUB(b.x)], 1u);
        const unsigned gen = old / nloc;
        if (old + 1u == (gen + 1u) * nloc) {
            __builtin_amdgcn_fence(__ATOMIC_RELEASE, "agent");
            asm volatile("s_waitcnt vmcnt(0)" ::: "memory");
            const unsigned og = xb_add(&bar[XB_TOP], 1u);
            const unsigned tg = og / nx;
            if (og + 1u == (tg + 1u) * nx) xb_add(&bar[XB_TOPGEN], 1u);
            else XB_SPIN(xb_ld(&bar[XB_TOPGEN]) == tg, bar);
            __builtin_amdgcn_fence(__ATOMIC_ACQUIRE, "agent");
            xb_add(&bar[XB_XGEN(b.x)], 1u);
            asm volatile("s_waitcnt vmcnt(0)" ::: "memory");
        } else {
            XB_SPIN(xb_ld(&bar[XB_XGEN(b.x)]) == gen, bar);
            __builtin_amdgcn_fence(__ATOMIC_ACQUIRE, "agent");
            asm volatile("s_waitcnt vmcnt(0)" ::: "memory");
        }
    }
    __syncthreads();
}


struct Args { const float* in[13]; float* out; unsigned char* ws; float invf[32]; int lo, hi; };

__global__ void __launch_bounds__(512, 2) fwd_mega(Args args) {
    extern __shared__ __attribute__((aligned(16))) unsigned char lds_raw[];
    LAS unsigned char* lds = (LAS unsigned char*)lds_raw;
    cg::grid_group grid = cg::this_grid();
    const int wave = __builtin_amdgcn_readfirstlane((int)threadIdx.x >> 6);
#define LANE_TID() const int lane = lane_id_asm(), tid = wave * 64 + lane
    const int G = gridDim.x, gw = blockIdx.x * 8 + wave, NGW = G * 8;
    const int lo = args.lo, hi = args.hi;
    volatile LAS unsigned* MISC = (volatile LAS unsigned*)(lds + 131072);
    if (threadIdx.x < 2) MISC[threadIdx.x] = 0u;
    __syncthreads();
    if (hi > NPHASE + 1) grid.sync();
    const XcdBarrier xbar = xcd_barrier_post((unsigned*)(args.ws + WS_CTL) + CW_XBAR, MISC);
#define IN(k) (lo <= (k) && (k) < hi)
#define WSP(T, off) ((T*)(args.ws + (off)))
#define SEAM(k) do { if (IN(k) && IN((k) + 1)) xcd_barrier(xbar); } while (0)

    for (int rep_ = 0; rep_ < NREP(0); ++rep_) { if (rep_) xcd_barrier(xbar);
    if (IN(0)) {
        LANE_TID(); (void)tid;
        LAS float* scr = (LAS float*)(lds + wave * 16384);
        const float* x = args.in[0]; const float* g_pre_mix = args.in[1]; const float* w_in = args.in[2];
        bf16_t* WinT = WSP(bf16_t, WS_WIN); float* tab = WSP(float, WS_TAB); bf16_t* Hb = WSP(bf16_t, WS_H);
        constexpr int I_IN = (D / 64) * (NIN / 32);
        {
            const int nfull = (I_IN / NGW) * NGW;
            for (int it = gw; it < nfull; it += NGW) transpose_item<1>(w_in, D, NIN, WinT, scr, it, lane);
            for (int it = nfull + (int)blockIdx.x; it < I_IN; it += G) transpose_sub<1>(w_in, D, NIN, WinT, scr, it, wave, lane);
        }
        for (int e = blockIdx.x * 512 + tid; e < S * 32; e += G * 512) {
            const int pos = e >> 5, f = e & 31;
            const float ang = (float)pos * args.invf[f];
            const double rev = (double)ang * 0.15915494309189535;
            const float fr = (float)(rev - floor(rev));
            tab[2 * e] = __builtin_amdgcn_cosf(fr); tab[2 * e + 1] = __builtin_amdgcn_sinf(fr);
        }
        {
            f32x4 gq[4];
#pragma unroll
            for (int j = 0; j < 4; ++j) gq[j] = ((const f32x4*)g_pre_mix)[lane + 64 * j];
            for (int m = gw; m < S; m += 2 * NGW) {
                const int m2 = m + NGW;
                const f32x4* xa = (const f32x4*)(x + (size_t)m * D) + lane; const f32x4* xb = (const f32x4*)(x + (size_t)(m2 < S ? m2 : m) * D) + lane;
                f32x4 va[4], vb[4]; float sa = 0.f, sb = 0.f;
#pragma unroll
                for (int j = 0; j < 4; ++j) { va[j] = __builtin_nontemporal_load(xa + 64 * j); vb[j] = __builtin_nontemporal_load(xb + 64 * j); }
#pragma unroll
                for (int j = 0; j < 4; ++j) { sa += (va[j][0] * va[j][0] + va[j][1] * va[j][1]) + (va[j][2] * va[j][2] + va[j][3] * va[j][3]); sb += (vb[j][0] * vb[j][0] + vb[j][1] * vb[j][1]) + (vb[j][2] * vb[j][2] + vb[j][3] * vb[j][3]); }
                const float ra = 1.0f / sqrtf(wave_sum(sa) * (1.0f / D) + EPS), rb = 1.0f / sqrtf(wave_sum(sb) * (1.0f / D) + EPS);
                u32x2* oa = (u32x2*)(Hb + (size_t)m * D) + lane; u32x2* ob = (u32x2*)(Hb + (size_t)m2 * D) + lane;
#pragma unroll
                for (int j = 0; j < 4; ++j) { u32x2 w; w.x = pk2(va[j][0] * ra * gq[j][0], va[j][1] * ra * gq[j][1]); w.y = pk2(va[j][2] * ra * gq[j][2], va[j][3] * ra * gq[j][3]); oa[64 * j] = w; }
                if (m2 < S) {
#pragma unroll
                    for (int j = 0; j < 4; ++j) { u32x2 w; w.x = pk2(vb[j][0] * rb * gq[j][0], vb[j][1] * rb * gq[j][1]); w.y = pk2(vb[j][2] * rb * gq[j][2], vb[j][3] * rb * gq[j][3]); ob[64 * j] = w; }
                }
            }
        }
    } }
    SEAM(0);

    for (int rep_ = 0; rep_ < NREP(1); ++rep_) { if (rep_) xcd_barrier(xbar);
    if (IN(1)) {
        LANE_TID(); (void)tid;
        pg8::Gemm g{WSP(bf16_t, WS_H), WSP(bf16_t, WS_WIN), S, NIN, D}; pg8::StaticOrder So; So.init(S, NIN, G, (int)blockIdx.x);
        EpiIn E{WSP(bf16_t, WS_QKV), WSP(bf16_t, WS_U), WSP(bf16_t, WS_GATES), WSP(float, WS_TAB)};
        pg8::gemm_phase<EpiIn, pg8::StaticOrder, true, true>(lds, g, So, E, wave, lane);
        {
            const int nwg = (S / 256) * (NIN / 256), rem = nwg % G;
            const bool helper = (rem == 0) || ((int)blockIdx.x >= rem);
            if (helper) {
                const int nh = (rem == 0) ? G : G - rem, hid = (rem == 0) ? (int)blockIdx.x : (int)blockIdx.x - rem;
                const float* w_mix = args.in[3]; const float* w_pa = args.in[5]; const float* w_pp = args.in[6]; const float* w_out = args.in[7]; const float* w_gu = args.in[10]; const float* w_down = args.in[11];
                bf16_t* WpaT = WSP(bf16_t, WS_WPA); bf16_t* WoutT = WSP(bf16_t, WS_WOUT); bf16_t* WguT = WSP(bf16_t, WS_WGU); bf16_t* WdT = WSP(bf16_t, WS_WD); bf16_t* WmT = WSP(bf16_t, WS_WMT);
                LAS float* scr = (LAS float*)(lds + wave * 16384);
                constexpr int I_PA = (256 / 64) * (D / 32), I_OUT = (D / 64) * (D / 32), I_GU = (D / 64) * (NGU / 32), I_DN = (FFH / 64) * (D / 32), I_MX = 4 * 2;
                constexpr int NDEF = 2 * I_PA + I_OUT + I_GU + I_DN + I_MX;
                for (int it = hid * 8 + wave; it < NDEF; it += nh * 8) {
                    int r = it;
                    if (r < I_MX) { const int gg = r >> 1; transpose_item<0>(w_mix + gg * 4096, 64, 64, WmT + gg * 4096, scr, r & 1, lane); continue; } r -= I_MX;
                    if (r < I_PA) { transpose_item<0>(w_pa, 256, D, WpaT, scr, r, lane, 512); continue; } r -= I_PA;
                    if (r < I_PA) { transpose_item<0>(w_pp, 256, D, WpaT + 256, scr, r, lane, 512); continue; } r -= I_PA;
                    if (r < I_OUT) { transpose_item<0>(w_out, D, D, WoutT, scr, r, lane); continue; } r -= I_OUT;
                    if (r < I_GU) { transpose_item<2>(w_gu, D, NGU, WguT, scr, r, lane); continue; } r -= I_GU;
                    transpose_item<0>(w_down, FFH, D, WdT, scr, r, lane);
                }
            }
        }
    } }
    SEAM(1);

    for (int rep_ = 0; rep_ < NREP(2); ++rep_) { if (rep_) xcd_barrier(xbar);
    if (IN(2)) {
        LANE_TID(); (void)tid;
        constexpr int RS = 192, NU = NHEAD * 128;
        const bf16_t* QKV = WSP(bf16_t, WS_QKV); const bf16_t* Ub = WSP(bf16_t, WS_U); bf16_t* OG = WSP(bf16_t, WS_OG); float* LSE = WSP(float, WS_LSE); bf16_t* YP = WSP(bf16_t, WS_OA);
        const bf16_t* WmT = WSP(bf16_t, WS_WMT); const float* pool_scale = args.in[4];
        LAS unsigned char* Kl = lds; LAS unsigned char* Vl = lds + 272 * RS;
        const int c = lane & 15, q = lane >> 4;
        const int rq = tid >> 3, ch = tid & 7, chs = ch ^ ((rq >> 2) & 3);
        for (int i = tid; i < 2 * 768; i += 512) { LAS unsigned char* base = (i < 768) ? Kl : Vl; const int j = (i < 768) ? i : i - 768; *(LAS unsigned*)(base + 256 * RS + 4 * j) = 0u; }
#define AU_OF(un_, h_, row0_, sh_, first_) const int h_ = (un_) >> 7, row0_ = ((un_) & 127) * 128, sh_ = 2 * (h_ >> 2); const bool first_ = (row0_ & ((S >> sh_) - 1)) == 0
#define KV_LOAD(kv, h_, row0_, first_) do { const bf16_t* pk_ = QKV + ((size_t)(NHEAD + (h_)) * S + ((row0_) - 128 + rq)) * HD + 8 * ch; const bf16_t* pv_ = QKV + ((size_t)(2 * NHEAD + (h_)) * S + ((row0_) - 128 + rq)) * HD + 8 * ch; \
            _Pragma("unroll") for (int i_ = 0; i_ < 4; ++i_) { if (i_ >= 2 || !(first_)) { kv[i_] = __builtin_nontemporal_load((const u32x4*)(pk_ + (size_t)i_ * 64 * HD)); kv[4 + i_] = __builtin_nontemporal_load((const u32x4*)(pv_ + (size_t)i_ * 64 * HD)); } \
                else { kv[i_] = (u32x4){0u, 0u, 0u, 0u}; kv[4 + i_] = (u32x4){0u, 0u, 0u, 0u}; } } } while (0)
#define KV_WRITE(kv) do { _Pragma("unroll") for (int i_ = 0; i_ < 4; ++i_) { *(LAS u32x4*)(Kl + (64 * i_ + rq) * RS + chs * 16) = kv[i_]; *(LAS u32x4*)(Vl + (64 * i_ + rq) * RS + chs * 16) = kv[4 + i_]; } } while (0)
#define Q_LOAD(qf, h_, row0_) do { const bf16_t* Qp_ = QKV + ((size_t)(h_) * S + ((row0_) + 16 * wave + c)) * HD + 8 * q; qf[0] = __builtin_nontemporal_load((const bf16x8*)Qp_); qf[1] = __builtin_nontemporal_load((const bf16x8*)(Qp_ + 32)); } while (0)
        typedef short s16x4 __attribute__((ext_vector_type(4)));
        u32x4 kv[8]; bf16x8 qf[2], qn[2];
        int un = blockIdx.x;
        if (un < NU) { AU_OF(un, h0, r0, s0, f0); (void)s0; KV_LOAD(kv, h0, r0, f0); Q_LOAD(qf, h0, r0); }
        for (; un < NU; un += G) {
            AU_OF(un, h, row0, sh, first);
            const int un2 = un + G; const bool has2 = un2 < NU;
            AU_OF((has2 ? un2 : un), h2, row2, sh2, first2); (void)sh2;
            __syncthreads();
            KV_WRITE(kv);
            __syncthreads();
            if (has2) { KV_LOAD(kv, h2, row2, first2); Q_LOAD(qn, h2, row2); }
            const int L = S >> sh;
            {
                const int qrow = row0 + 16 * wave + c;
                f32x4 sc[10];
#pragma unroll
                for (int t = 0; t < 10; ++t) {
                    const int krow = 16 * wave + 32 * (t >> 1) + 8 * (c >> 2) + 4 * (t & 1) + (c & 3);
                    const int kx = (q ^ ((2 * (c >> 2) + (t & 1)) & 3)) * 16;
                    const bf16x8 k0 = *(const LAS bf16x8*)(Kl + krow * RS + kx), k1 = *(const LAS bf16x8*)(Kl + krow * RS + 64 + kx);
                    f32x4 a = (f32x4){0.f, 0.f, 0.f, 0.f};
                    a = __builtin_amdgcn_mfma_f32_16x16x32_bf16(k0, qf[0], a, 0, 0, 0);
                    a = __builtin_amdgcn_mfma_f32_16x16x32_bf16(k1, qf[1], a, 0, 0, 0);
                    sc[t] = a;
                }
                const int ql = 128 + 16 * wave + c;
                float mx = -1e30f;
#pragma unroll
                for (int t = 0; t < 10; ++t)
#pragma unroll
                    for (int rg = 0; rg < 4; ++rg) {
                        const int kl = 16 * wave + 32 * (t >> 1) + 8 * q + 4 * (t & 1) + rg, dist = ql - kl;
                        const bool valid = dist >= 0 && dist <= 128 && (kl >= 128 || !first);
                        const float sv = valid ? sc[t][rg] * 0.18033688011112042f : -1e30f;
                        sc[t][rg] = sv; mx = fmaxf(mx, sv);
                    }
                mx = fmaxf(mx, __shfl_xor(mx, 16)); mx = fmaxf(mx, __shfl_xor(mx, 32));
                float lsum = 0.f;
#pragma unroll
                for (int t = 0; t < 10; ++t)
#pragma unroll
                    for (int rg = 0; rg < 4; ++rg) { const float pv = __builtin_amdgcn_exp2f(sc[t][rg] - mx); sc[t][rg] = pv; lsum += pv; }
                lsum += __shfl_xor(lsum, 16); lsum += __shfl_xor(lsum, 32);
                f32x4 o[4];
#pragma unroll
                for (int dt = 0; dt < 4; ++dt) o[dt] = (f32x4){0.f, 0.f, 0.f, 0.f};
#pragma unroll
                for (int cc = 0; cc < 5; ++cc) {
                    u32x4 pw; pw.x = pk2(sc[2 * cc][0], sc[2 * cc][1]); pw.y = pk2(sc[2 * cc][2], sc[2 * cc][3]); pw.z = pk2(sc[2 * cc + 1][0], sc[2 * cc + 1][1]); pw.w = pk2(sc[2 * cc + 1][2], sc[2 * cc + 1][3]);
                    const bf16x8 pf = __builtin_bit_cast(bf16x8, pw);
                    LAS unsigned char* vb = Vl + (16 * wave + 32 * cc + 8 * q + (c >> 2)) * RS + 8 * (c & 1);
                    const int px = (c >> 1) & 1, x0 = (2 * q) & 3, x1 = (2 * q + 1) & 3;
#pragma unroll
                    for (int dt = 0; dt < 4; ++dt) {
                        const s16x4 v0 = __builtin_bit_cast(s16x4, __builtin_amdgcn_ds_read_tr16_b64_v4i16((LAS s16x4*)(vb + 16 * ((2 * dt + px) ^ x0))));
                        const s16x4 v1 = __builtin_bit_cast(s16x4, __builtin_amdgcn_ds_read_tr16_b64_v4i16((LAS s16x4*)(vb + 4 * RS + 16 * ((2 * dt + px) ^ x1))));
                        bf16x8 vf; vf[0] = v0[0]; vf[1] = v0[1]; vf[2] = v0[2]; vf[3] = v0[3]; vf[4] = v1[0]; vf[5] = v1[1]; vf[6] = v1[2]; vf[7] = v1[3];
                        o[dt] = __builtin_amdgcn_mfma_f32_16x16x32_bf16(vf, pf, o[dt], 0, 0, 0);
                    }
                }
                const float inv = 1.0f / lsum;
                const int tok = ((qrow & (L - 1)) << sh) + (qrow >> (14 - sh));
                bf16_t* op = OG + ((size_t)h * S + tok) * HD + 4 * q;
#pragma unroll
                for (int dt = 0; dt < 4; ++dt) { u32x2 w; w.x = pk2(o[dt][0] * inv, o[dt][1] * inv); w.y = pk2(o[dt][2] * inv, o[dt][3] * inv); *(u32x2*)(op + 16 * dt) = w; }
                if (q == 0) LSE[(size_t)h * S + tok] = (mx + __log2f(lsum)) * 0.6931471805599453f;
            }
            qf[0] = qn[0]; qf[1] = qn[1];
        }
#undef AU_OF
#undef KV_LOAD
#undef KV_WRITE
#undef Q_LOAD
        for (int wu = gw; wu < (S / 16) * 4; wu += NGW) {
            const int tt = wu >> 2, g = wu & 3;
            if (g == 0) pool_unit<2>(Ub, WmT, pool_scale, YP, tt, 0, c, q);
            else if (g == 1) pool_unit<4>(Ub, WmT, pool_scale, YP, tt, 1, c, q);
            else if (g == 2) pool_unit<8>(Ub, WmT, pool_scale, YP, tt, 2, c, q);
            else pool_unit<16>(Ub, WmT, pool_scale, YP, tt, 3, c, q);
        }
    } }
    SEAM(2);

    for (int rep_ = 0; rep_ < NREP(3); ++rep_) { if (rep_) xcd_barrier(xbar);
    if (IN(3)) {
        LANE_TID(); (void)tid;
        const bf16_t* OG = WSP(bf16_t, WS_OG); const float* LSE = WSP(float, WS_LSE); bf16_t* OA = WSP(bf16_t, WS_OA);
        for (int e0 = blockIdx.x * 512 + tid; e0 < S * 32; e0 += 4 * G * 512) {
            float l0[4], l1[4], l2[4]; u32x4 v0[4], v1[4], v2[4];
#pragma unroll
            for (int k = 0; k < 4; ++k) {
                const int e = e0 + k * G * 512, ec = e < S * 32 ? e : e0;
                const int d8 = ec & 7, j = (ec >> 3) & 3, t = ec >> 5;
                l0[k] = LSE[(size_t)(0 + j) * S + t]; l1[k] = LSE[(size_t)(4 + j) * S + t]; l2[k] = LSE[(size_t)(8 + j) * S + t];
                v0[k] = __builtin_nontemporal_load((const u32x4*)(OG + ((size_t)(0 + j) * S + t) * HD + 8 * d8)); v1[k] = __builtin_nontemporal_load((const u32x4*)(OG + ((size_t)(4 + j) * S + t) * HD + 8 * d8)); v2[k] = __builtin_nontemporal_load((const u32x4*)(OG + ((size_t)(8 + j) * S + t) * HD + 8 * d8));
            }
#pragma unroll
            for (int k = 0; k < 4; ++k) {
                const int e = e0 + k * G * 512;
                if (e < S * 32) {
                    const int d8 = e & 7, j = (e >> 3) & 3, t = e >> 5;
                    const float mx = fmaxf(l0[k], fmaxf(l1[k], l2[k]));
                    float w0 = __expf(l0[k] - mx), w1 = __expf(l1[k] - mx), w2 = __expf(l2[k] - mx);
                    const float inv = __builtin_amdgcn_rcpf(w0 + w1 + w2); w0 *= inv; w1 *= inv; w2 *= inv;
                    u32x4 o;
#pragma unroll
                    for (int i = 0; i < 4; ++i) {
                        const float a = w0 * bf2f(v0[k][i] & 0xffffu) + w1 * bf2f(v1[k][i] & 0xffffu) + w2 * bf2f(v2[k][i] & 0xffffu);
                        const float bb = w0 * bf2f(v0[k][i] >> 16) + w1 * bf2f(v1[k][i] >> 16) + w2 * bf2f(v2[k][i] >> 16);
                        o[i] = pk2(a, bb);
                    }
                    *(u32x4*)(OA + (size_t)t * 512 + 64 * j + 8 * d8) = o;
                }
            }
        }
    } }
    SEAM(3);

    for (int rep_ = 0; rep_ < NREP(4); ++rep_) { if (rep_) xcd_barrier(xbar);
    if (IN(4)) {
        LANE_TID(); (void)tid;
        int K1 = 512; asm volatile("" : "+s"(K1));
        pg8::Gemm g{WSP(bf16_t, WS_OA), WSP(bf16_t, WS_WPA), S, D, K1}; pg8::StaticOrder So; So.init(S, D, G, (int)blockIdx.x);
        EpiGate2 E{WSP(bf16_t, WS_GATES), WSP(bf16_t, WS_H)};
        pg8::gemm_phase<EpiGate2, pg8::StaticOrder, true, true>(lds, g, So, E, wave, lane);
    } }
    SEAM(4);

    { const int rep_ = 0; (void)rep_;
    if (IN(5)) {
        LANE_TID(); (void)tid;
        pg8::Gemm g{WSP(bf16_t, WS_H), WSP(bf16_t, WS_WOUT), S, D, D}; pg8::StaticOrder So; So.init(S, D, G, (int)blockIdx.x);
        RowStats st1{WSP(unsigned, WS_XBUF + (size_t)rep_ * 786432), WSP(unsigned, WS_CTL) + (rep_ ? 20480 : 1024)}; RowStats st2{WSP(unsigned, WS_XBUF + 262144 + (size_t)rep_ * 786432), WSP(unsigned, WS_CTL) + (rep_ ? 20480 : 1024) + 4096};
        EpiRmsResRms E{args.in[0], WSP(bf16_t, WS_X1), WSP(bf16_t, WS_H2), args.in[8], args.in[9], st1, st2};
        pg8::gemm_phase<EpiRmsResRms, pg8::StaticOrder, false, true>(lds, g, So, E, wave, lane);
    } }
    SEAM(5);

    for (int rep_ = 0; rep_ < NREP(7); ++rep_) { if (rep_) xcd_barrier(xbar);
    if (IN(7)) {
        LANE_TID(); (void)tid;
        pg8::Gemm g{WSP(bf16_t, WS_H2), WSP(bf16_t, WS_WGU), S, NGU, D}; pg8::StaticOrder So; So.init(S, NGU, G, (int)blockIdx.x);
        EpiSwiglu E{WSP(bf16_t, WS_ACT)};
        pg8::gemm_phase<EpiSwiglu, pg8::StaticOrder, true, true>(lds, g, So, E, wave, lane);
    } }
    SEAM(7);

    { const int rep_ = 0; (void)rep_;
    if (IN(8)) {
        LANE_TID(); (void)tid;
        pg8::Gemm g{WSP(bf16_t, WS_ACT), WSP(bf16_t, WS_WD), S, D, FFH}; pg8::StaticOrder So; So.init(S, D, G, (int)blockIdx.x);
        RowStats st{WSP(unsigned, WS_XBUF + 2 * 262144 + (size_t)rep_ * 786432), WSP(unsigned, WS_CTL) + (rep_ ? 20480 : 1024) + 2 * 4096};
        EpiRmsRes E{WSP(bf16_t, WS_X1), args.out, args.in[12], st};
        pg8::gemm_phase<EpiRmsRes, pg8::StaticOrder, false, true>(lds, g, So, E, wave, lane);
    } }
#undef IN
#undef LANE_TID
#undef WSP
#undef SEAM
}

extern "C" void kernel_launch(void* const* d_in, const int* in_sizes, int n_in, void* d_out, int out_size, void* d_ws, size_t ws_size, hipStream_t stream) {
    static int grid = 0;
    if (grid == 0) {
        if (n_in != 13 || in_sizes[0] != S * D || out_size != S * D || ws_size < WS_END) { fprintf(stderr, "kernel_launch: unexpected shapes (n_in %d, in0 %d, out %d, ws %zu)\n", n_in, n_in > 0 ? in_sizes[0] : -1, out_size, ws_size); grid = -1; return; }
        int dev = 0, cus = 0, per_cu = 0;
        (void)hipGetDevice(&dev);
        (void)hipDeviceGetAttribute(&cus, hipDeviceAttributeMultiprocessorCount, dev);
        if (hipFuncSetAttribute((const void*)fwd_mega, hipFuncAttributeMaxDynamicSharedMemorySize, LDS_BYTES) != hipSuccess) fprintf(stderr, "kernel_launch: hipFuncSetAttribute failed\n");
        if (hipOccupancyMaxActiveBlocksPerMultiprocessor(&per_cu, (const void*)fwd_mega, 512, LDS_BYTES) != hipSuccess || per_cu < 1) { fprintf(stderr, "kernel_launch: occupancy query says %d\n", per_cu); per_cu = 1; }
        (void)hipGetLastError();
        if (cus <= 0) cus = 256;
        grid = cus * per_cu;
    }
    if (grid < 0) return;
    Args a{};
    for (int i = 0; i < 13; ++i) a.in[i] = (const float*)d_in[i];
    a.out = (float*)d_out; a.ws = (unsigned char*)d_ws;
    for (int f = 0; f < 32; ++f) a.invf[f] = (float)pow(10000.0, -(double)f / 32.0);
    a.lo = 0; a.hi = NPHASE;
    (void)hipMemsetAsync((unsigned char*)d_ws + WS_CTL, 0, CTL_ZERO_BYTES, stream);
    void* kargs[] = {&a};
    hipError_t e = hipLaunchCooperativeKernel((const void*)fwd_mega, dim3(grid), dim3(512), kargs, LDS_BYTES, stream);
    if (e != hipSuccess) fprintf(stderr, "kernel_launch: cooperative launch failed: %s (grid %d)\n", hipGetErrorString(e), grid);
}
```
